# Optimizing an MI355X kernel written in HIP

```python
import math
import jax, jax.numpy as jnp
from jax import lax
import numpy as np

D_MODEL = 1024
BATCH = 8
SEQ = 2048
DEPTH = 2
DEC_BATCH = 128
DEC_SEQ = 4
PAST_LEN = 8192
PAGE_SIZE = 128

N_A_LAYERS = DEPTH // 2
N_B_LAYERS = DEPTH - N_A_LAYERS

GLA_HEADS = 4
GLA_DV = 192
GLA_DK = GLA_DV // 2
GLA_GATE_RANK = 16
GLA_GATE_NORM = 16.0
GLA_CHUNK = 64
GLA_QK = GLA_HEADS * GLA_DK
GLA_V = GLA_HEADS * GLA_DV

HEAD_DIM = 64
SWA_Q_HEADS = 12
SWA_KV_HEADS = 3
WINDOW = 128
ROT_DIM = HEAD_DIM // 4
ROPE_THETA = 500000.0
SWA_Q = SWA_Q_HEADS * HEAD_DIM
KV_SHARED = 2 * SWA_KV_HEADS * HEAD_DIM

MEM_TOKENS = 256
MEM_HEADS = 4
MEM_HEAD_DIM = 64
MEM_Q = MEM_HEADS * MEM_HEAD_DIM

FFN_DIM = 2816
EPS = 1e-6

A_IN = 2 * GLA_QK + 2 * GLA_V + GLA_GATE_RANK + MEM_Q
A_SPLITS = [GLA_QK, 2 * GLA_QK, 2 * GLA_QK + GLA_V, 2 * GLA_QK + 2 * GLA_V,
            2 * GLA_QK + 2 * GLA_V + GLA_GATE_RANK]
A_MIX = GLA_V + MEM_Q
B_IN = SWA_Q + MEM_Q
B_MIX = SWA_Q + MEM_Q

kernel_name = 'yoco_gla_swa_sink_memxattn_step'


def rmsnorm(x, g):
    xf = x.astype(jnp.float32)
    y = xf * lax.rsqrt(jnp.mean(xf * xf, axis=-1, keepdims=True) + EPS)
    return (y * g.astype(jnp.float32)).astype(x.dtype)


def swiglu_half(x, g, w_gu, w_down):
    h = rmsnorm(x, g)
    gate, up = jnp.split(h @ w_gu, 2, axis=-1)
    return 0.5 * ((jax.nn.silu(gate) * up) @ w_down)


def rope_partial(x, pos):
    half = ROT_DIM // 2
    inv_freq = jnp.exp(-math.log(ROPE_THETA) * jnp.arange(0, ROT_DIM, 2, dtype=jnp.float32) / ROT_DIM)
    ang = pos[:, None] * inv_freq[None, :]
    cos = jnp.cos(ang)[None, :, None, :].astype(x.dtype)
    sin = jnp.sin(ang)[None, :, None, :].astype(x.dtype)
    x1 = x[..., :half]
    x2 = x[..., half:ROT_DIM]
    return jnp.concatenate([x1 * cos - x2 * sin, x2 * cos + x1 * sin, x[..., ROT_DIM:]], axis=-1)


def mem_kv(mem, g, w):
    B, M, _ = mem.shape
    kv = (rmsnorm(mem, g) @ w).reshape(B, M, 2, MEM_HEADS, MEM_HEAD_DIM)
    return kv[:, :, 0], kv[:, :, 1]


def mem_attention(q, mk, mv):
    s = jnp.einsum('blhd,bmhd->bhlm', q, mk).astype(jnp.float32) * MEM_HEAD_DIM ** -0.5
    p = jax.nn.softmax(s, axis=-1).astype(mv.dtype)
    return jnp.einsum('bhlm,bmhd->blhd', p, mv)


def sink_softmax(s, sinks):
    sink = jnp.broadcast_to(sinks.astype(jnp.float32)[:, :, None, None], s.shape[:-1] + (1,))
    p = jax.nn.softmax(jnp.concatenate([s, sink], axis=-1), axis=-1)
    return p[..., :-1]


def gla_chunked(q, k, v, log_a):
    B, L, H, DK = q.shape
    DV = v.shape[-1]
    C = GLA_CHUNK
    nc = L // C

    def to_chunks(t):
        return t.reshape(B, nc, C, H, t.shape[-1]).transpose(1, 0, 3, 2, 4).astype(jnp.float32)

    qc, kc, vc, gc = to_chunks(q), to_chunks(k), to_chunks(v), to_chunks(log_a)
    causal = jnp.tril(jnp.ones((C, C), dtype=bool))

    def step(S, inp):
        qi, ki, vi, gi = inp
        b = jnp.cumsum(gi, axis=2)
        diff = b[:, :, :, None, :] - b[:, :, None, :, :]
        decay = jnp.exp(jnp.where(causal[:, :, None], diff, -jnp.inf))
        A = jnp.einsum('bhid,bhjd,bhijd->bhij', qi, ki, decay)
        o = jnp.einsum('bhij,bhjv->bhiv', A, vi) + jnp.einsum('bhid,bhdv->bhiv', qi * jnp.exp(b), S)
        b_last = b[:, :, -1:, :]
        S = jnp.exp(b_last[:, :, 0, :])[..., None] * S + jnp.einsum(
            'bhjd,bhjv->bhdv', ki * jnp.exp(b_last - b), vi)
        return S, o

    S0 = jnp.zeros((B, H, DK, DV), jnp.float32)
    S, o = lax.scan(step, S0, (qc, kc, vc, gc))
    return o.transpose(1, 0, 3, 2, 4).reshape(B, L, H, DV), S


def gla_recurrent(q, k, v, log_a, S0):
    def step(S, inp):
        qt, kt, vt, gt = inp
        S = jnp.exp(gt)[..., None] * S + kt[..., :, None] * vt[..., None, :]
        return S, jnp.einsum('bhk,bhkv->bhv', qt, S)

    xs = tuple(t.astype(jnp.float32).transpose(1, 0, 2, 3) for t in (q, k, v, log_a))
    S, o = lax.scan(step, S0.astype(jnp.float32), xs)
    return o.transpose(1, 0, 2, 3), S


def swa_prompt(q, k, v, sinks):
    B, L, HQ, HD = q.shape
    KVH = k.shape[2]
    G = HQ // KVH
    BLK = WINDOW
    nb = L // BLK
    qb = q.reshape(B, nb, BLK, KVH, G, HD)

    def band(t):
        tb = t.reshape(B, nb, BLK, KVH, HD)
        prev = jnp.concatenate([jnp.zeros_like(tb[:, :1]), tb[:, :-1]], axis=1)
        return jnp.concatenate([prev, tb], axis=2)

    kb, vb = band(k), band(v)
    s = jnp.einsum('bnqkgd,bnskd->bnkgqs', qb, kb).astype(jnp.float32) * HD ** -0.5
    blk = jnp.arange(nb)[:, None, None]
    qpos = blk * BLK + jnp.arange(BLK)[None, :, None]
    kpos = (blk - 1) * BLK + jnp.arange(2 * BLK)[None, None, :]
    d = qpos - kpos
    mask = (d >= 0) & (d < WINDOW) & (kpos >= 0)
    s = jnp.where(mask[None, :, None, None], s, -jnp.inf)
    p = sink_softmax(s, sinks.reshape(KVH, G))
    o = jnp.einsum('bnkgqs,bnskd->bnqkgd', p.astype(vb.dtype), vb)
    return o.reshape(B, L, HQ * HD)


def swa_sample(q, k_all, v_all, sinks):
    B, Lq, HQ, HD = q.shape
    KVH = k_all.shape[2]
    G = HQ // KVH
    W = k_all.shape[1] - Lq
    qg = q.reshape(B, Lq, KVH, G, HD)
    s = jnp.einsum('bqkgd,bskd->bkgqs', qg, k_all).astype(jnp.float32) * HD ** -0.5
    d = (W + jnp.arange(Lq))[:, None] - jnp.arange(W + Lq)[None, :]
    mask = (d >= 0) & (d < WINDOW)
    s = jnp.where(mask, s, -jnp.inf)
    p = sink_softmax(s, sinks.reshape(KVH, G))
    o = jnp.einsum('bkgqs,bskd->bqkgd', p.astype(v_all.dtype), v_all)
    return o.reshape(B, Lq, HQ * HD)


def trunk(x, pos, mem_k, mem_v, gla_s0, buf_k, buf_v, w, decode):
    B, L, _ = x.shape
    gla_states = []
    for l in range(DEPTH):
        if l == N_A_LAYERS:
            kv = (rmsnorm(x, w['kv_norm']) @ w['w_kv']).reshape(B, L, 2, SWA_KV_HEADS, HEAD_DIM)
            k_sh = rope_partial(kv[:, :, 0], pos)
            v_sh = kv[:, :, 1]
            if decode:
                k_att = jnp.concatenate([buf_k.astype(k_sh.dtype), k_sh], axis=1)
                v_att = jnp.concatenate([buf_v.astype(v_sh.dtype), v_sh], axis=1)
                n_keep = buf_k.shape[1]
            else:
                k_att, v_att = k_sh, v_sh
                n_keep = min(WINDOW, L)
            swa_k_new = k_att[:, -n_keep:]
            swa_v_new = v_att[:, -n_keep:]

        x = x + swiglu_half(x, w['ffn1_norm'][l], w['ffn1_w_gu'][l], w['ffn1_w_down'][l])
        h = rmsnorm(x, w['mix_norm'][l])
        if l < N_A_LAYERS:
            a = l
            q, k, v, r, g_lr, mq = jnp.split(h @ w['a_w_in'][a], A_SPLITS, axis=-1)
            q = q.reshape(B, L, GLA_HEADS, GLA_DK) * GLA_DK ** -0.5
            k = k.reshape(B, L, GLA_HEADS, GLA_DK)
            v = v.reshape(B, L, GLA_HEADS, GLA_DV)
            log_a = jax.nn.log_sigmoid((g_lr @ w['a_w_gate'][a] + w['a_b_gate'][a]).astype(jnp.float32))
            log_a = (log_a / GLA_GATE_NORM).reshape(B, L, GLA_HEADS, GLA_DK)
            if decode:
                o, S = gla_recurrent(q, k, v, log_a, gla_s0[a])
            else:
                o, S = gla_chunked(q, k, v, log_a)
            gla_states.append(S.astype(x.dtype))
            o = rmsnorm(o.astype(x.dtype), w['a_out_norm'][a]) * jax.nn.silu(r.reshape(B, L, GLA_HEADS, GLA_DV))
            tok = o.reshape(B, L, GLA_V)
            w_out = w['a_w_out'][a]
        else:
            bi = l - N_A_LAYERS
            qs, mq = jnp.split(h @ w['b_w_in'][bi], [SWA_Q], axis=-1)
            qs = rope_partial(qs.reshape(B, L, SWA_Q_HEADS, HEAD_DIM), pos)
            if decode:
                tok = swa_sample(qs, k_att, v_att, w['b_sinks'][bi])
            else:
                tok = swa_prompt(qs, k_sh, v_sh, w['b_sinks'][bi])
            w_out = w['b_w_out'][bi]
        mo = mem_attention(mq.reshape(B, L, MEM_HEADS, MEM_HEAD_DIM), mem_k[l], mem_v[l]).reshape(B, L, MEM_Q)
        x = x + jnp.concatenate([tok, mo], axis=-1) @ w_out
        x = x + swiglu_half(x, w['ffn2_norm'][l], w['ffn2_w_gu'][l], w['ffn2_w_down'][l])
    y = rmsnorm(x, w['final_norm'])
    return y, jnp.stack(gla_states), swa_k_new, swa_v_new


def setup_inputs(seed: int = 0) -> dict:
    key = jax.random.key(seed)
    ks = iter(jax.random.split(key, 48))

    def nrm(shape, scale=1.0):
        return jax.random.normal(next(ks), shape, jnp.float32) * scale

    def gain(shape):
        return 1.0 + 0.05 * nrm(shape)

    w_buf = min(WINDOW, PAST_LEN)
    return {
        'x_prompt': nrm((BATCH, SEQ, D_MODEL)),
        'x_sample': nrm((DEC_BATCH, DEC_SEQ, D_MODEL)),
        'state_gla': nrm((N_A_LAYERS, DEC_BATCH, GLA_HEADS, GLA_DK, GLA_DV)),
        'cache_swa_k': nrm((DEC_BATCH, w_buf, SWA_KV_HEADS, HEAD_DIM)),
        'cache_swa_v': nrm((DEC_BATCH, w_buf, SWA_KV_HEADS, HEAD_DIM)),
        'cache_mem_k': nrm((DEPTH, DEC_BATCH, MEM_TOKENS, MEM_HEADS, MEM_HEAD_DIM)),
        'cache_mem_v': nrm((DEPTH, DEC_BATCH, MEM_TOKENS, MEM_HEADS, MEM_HEAD_DIM)),
        'mem_prompt': nrm((BATCH, MEM_TOKENS, D_MODEL)),
        'ffn1_norm': gain((DEPTH, D_MODEL)),
        'ffn1_w_gu': nrm((DEPTH, D_MODEL, 2 * FFN_DIM), D_MODEL ** -0.5),
        'ffn1_w_down': nrm((DEPTH, FFN_DIM, D_MODEL), FFN_DIM ** -0.5),
        'mix_norm': gain((DEPTH, D_MODEL)),
        'ffn2_norm': gain((DEPTH, D_MODEL)),
        'ffn2_w_gu': nrm((DEPTH, D_MODEL, 2 * FFN_DIM), D_MODEL ** -0.5),
        'ffn2_w_down': nrm((DEPTH, FFN_DIM, D_MODEL), FFN_DIM ** -0.5),
        'mem_norm': gain((DEPTH, D_MODEL)),
        'mem_w_kv': nrm((DEPTH, D_MODEL, 2 * MEM_Q), D_MODEL ** -0.5),
        'a_w_in': nrm((N_A_LAYERS, D_MODEL, A_IN), D_MODEL ** -0.5),
        'a_w_gate': nrm((N_A_LAYERS, GLA_GATE_RANK, GLA_QK), GLA_GATE_RANK ** -0.5),
        'a_b_gate': nrm((N_A_LAYERS, GLA_QK), 0.1),
        'a_out_norm': gain((N_A_LAYERS, GLA_DV)),
        'a_w_out': nrm((N_A_LAYERS, A_MIX, D_MODEL), A_MIX ** -0.5),
        'kv_norm': gain((D_MODEL,)),
        'w_kv': nrm((D_MODEL, KV_SHARED), D_MODEL ** -0.5),
        'b_w_in': nrm((N_B_LAYERS, D_MODEL, B_IN), D_MODEL ** -0.5),
        'b_sinks': nrm((N_B_LAYERS, SWA_Q_HEADS), 0.5),
        'b_w_out': nrm((N_B_LAYERS, B_MIX, D_MODEL), B_MIX ** -0.5),
        'final_norm': gain((D_MODEL,)),
    }


def reference(x_prompt, x_sample, state_gla, cache_swa_k, cache_swa_v, cache_mem_k, cache_mem_v,
              mem_prompt, ffn1_norm, ffn1_w_gu, ffn1_w_down, mix_norm, ffn2_norm, ffn2_w_gu,
              ffn2_w_down, mem_norm, mem_w_kv, a_w_in, a_w_gate, a_b_gate, a_out_norm, a_w_out,
              kv_norm, w_kv, b_w_in, b_sinks, b_w_out, final_norm):
    w = dict(ffn1_norm=ffn1_norm, ffn1_w_gu=ffn1_w_gu, ffn1_w_down=ffn1_w_down, mix_norm=mix_norm,
             ffn2_norm=ffn2_norm, ffn2_w_gu=ffn2_w_gu, ffn2_w_down=ffn2_w_down,
             a_w_in=a_w_in, a_w_gate=a_w_gate, a_b_gate=a_b_gate, a_out_norm=a_out_norm,
             a_w_out=a_w_out, kv_norm=kv_norm, w_kv=w_kv, b_w_in=b_w_in, b_sinks=b_sinks,
             b_w_out=b_w_out, final_norm=final_norm)

    mks, mvs = [], []
    for l in range(DEPTH):
        mk, mv = mem_kv(mem_prompt, mem_norm[l], mem_w_kv[l])
        mks.append(mk)
        mvs.append(mv)
    mem_k_prompt = jnp.stack(mks)
    mem_v_prompt = jnp.stack(mvs)

    pos_p = jnp.arange(x_prompt.shape[1], dtype=jnp.float32)
    y_prompt, gla_prompt, swa_k_prompt, swa_v_prompt = trunk(
        x_prompt, pos_p, mem_k_prompt, mem_v_prompt, None, None, None, w, False)

    pos_s = PAST_LEN + jnp.arange(x_sample.shape[1], dtype=jnp.float32)
    y_sample, gla_sample, swa_k_sample, swa_v_sample = trunk(
        x_sample, pos_s, cache_mem_k, cache_mem_v, state_gla, cache_swa_k, cache_swa_v, w, True)

    return (y_prompt, y_sample, gla_prompt, gla_sample, swa_k_prompt, swa_v_prompt,
            swa_k_sample, swa_v_sample, mem_k_prompt, mem_v_prompt)
```

```cpp
#include <hip/hip_runtime.h>
#include <cstdio>
#include <cstdint>

#ifndef MK_ONE_LAUNCH
#define MK_ONE_LAUNCH 1
#endif

namespace pg8 {
#define PG8_LAS __attribute__((address_space(3)))
typedef unsigned short bf16_t;
typedef short bf16x8 __attribute__((ext_vector_type(8)));
typedef float f32x4 __attribute__((ext_vector_type(4)));
typedef unsigned u32x4 __attribute__((ext_vector_type(4)));
constexpr int BM = 256, BK = 64, HALF = 128, HTB = HALF * BK * 2  , STAGE_BYTES = 8 * HTB, NXCD = 8, WGM = 8;

__host__ __device__ __forceinline__ int lds_byte(int r, int c) { const int st = (r >> 4) * 2 + (c >> 5), rr = r & 15, cc = c & 31, ob = rr * 64 + cc * 2; return st * 1024 + (ob ^ (((ob >> 9) & 1) << 5)); }
__host__ __device__ __forceinline__ void stage_rc(int b, int& R, int& C) { const int st = b / 1024, sb = b % 1024, swz = sb ^ (((sb >> 9) & 1) << 5); R = (st >> 1) * 16 + swz / 64; C = (st & 1) * 32 + (swz % 64) / 2; }
__host__ __device__ __forceinline__ int perm32(int rho) { const int n = rho >> 4, i = rho & 15; return 8 * (i >> 2) + 4 * n + (i & 3); }

struct Unit { int pm, pn; };
struct Gemm { const bf16_t* A; const bf16_t* Bt; int M, N, K; };

struct StaticOrder {
    int nM, nN, nwg, G, c;
    __host__ __device__ void init(int M, int N, int G_, int c_) { nM = M / BM; nN = N / BM; nwg = nM * nN; G = G_; c = c_; }
    __host__ __device__ bool next(int i, Unit& u) const {
        const long L = (long)i * G + c; if (L >= nwg) return false;
        int wgid = (int)L; { const int q = nwg / NXCD, r = nwg % NXCD, xcd = wgid % NXCD, off = wgid / NXCD; wgid = (xcd < r ? xcd * (q + 1) : r * (q + 1) + (xcd - r) * q) + off; }
        const int nig = WGM * nN, gid = wgid / nig, fm = gid * WGM, gsz = (nM - fm) < WGM ? (nM - fm) : WGM;
        u.pm = fm + ((wgid % nig) % gsz); u.pn = (wgid % nig) / gsz; return true;
    }
    __device__ __forceinline__ void a_ready(const Unit&) const {}
    __device__ __forceinline__ void done(const Unit&) const {}
};


constexpr int MPROWS = 16384, FFD = 2816;
typedef float f32x2_t __attribute__((ext_vector_type(2))); typedef __bf16 bf16x2_t __attribute__((ext_vector_type(2)));
__device__ __forceinline__ unsigned pk2(float lo, float hi) { f32x2_t v = {lo, hi}; bf16x2_t b = __builtin_convertvector(v, bf16x2_t); return __builtin_bit_cast(unsigned, b); }
__device__ __forceinline__ u32x4 pk8(f32x4 a, f32x4 b) { u32x4 w; w.x = pk2(a[0], a[1]); w.y = pk2(a[2], a[3]); w.z = pk2(b[0], b[1]); w.w = pk2(b[2], b[3]); return w; }
__device__ __forceinline__ float silu_f(float g) { return g * __builtin_amdgcn_rcpf(1.0f + __builtin_amdgcn_exp2f(-1.4426950408889634f * g)); }

struct EpiGU { static constexpr bool PERM = true, RSTD = true; const float* ssq; bf16_t* H;
    __device__ __forceinline__ void operator()(const f32x4 (&acc)[2][2][4][2], const Unit& u, int wr, int wc, int fr, int fq, const PG8_LAS float* tab) const {
        const int col0 = u.pn * 128 + wc * 32 + 8 * fq;
#pragma unroll
        for (int ai = 0; ai < 2; ++ai)
#pragma unroll
            for (int m = 0; m < 4; ++m) { const int lr = ai * HALF + wr * 64 + m * 16 + fr; const float rs = tab[lr];
                bf16_t* rowp = H + (size_t)(u.pm * BM + lr) * FFD + col0;
                f32x4 h0, h1;
#pragma unroll
                for (int e = 0; e < 4; ++e) { h0[e] = silu_f(acc[ai][0][m][0][e] * rs) * (acc[ai][1][m][0][e] * rs); h1[e] = silu_f(acc[ai][0][m][1][e] * rs) * (acc[ai][1][m][1][e] * rs); }
                *(u32x4*)rowp = pk8(h0, h1); }
    }
};
struct EpiDown { static constexpr bool PERM = false, RSTD = false; const float* ssq_unused; const float* baseP; const float* baseS; float* out; bf16_t* xb; float* ssq; float scale;
    __device__ __forceinline__ void operator()(const f32x4 (&acc)[2][2][4][2], const Unit& u, int wr, int wc, int fr, int fq, const PG8_LAS float* tab) const {
        const int col0 = u.pn * BM + wc * 32 + 4 * fq;
        typedef unsigned u32x2v __attribute__((ext_vector_type(2)));
#pragma unroll
        for (int ai = 0; ai < 2; ++ai)
#pragma unroll
            for (int m = 0; m < 4; ++m) { const int grow = u.pm * BM + ai * HALF + wr * 64 + m * 16 + fr;
                const float* bp = (grow < MPROWS) ? baseP + (size_t)grow * 1024 : baseS + (size_t)(grow - MPROWS) * 1024;
                float ss = 0.f;
#pragma unroll
                for (int bj = 0; bj < 2; ++bj)
#pragma unroll
                    for (int n = 0; n < 2; ++n) { const int c = col0 + bj * HALF + n * 16; const f32x4 b = *(const f32x4*)(bp + c); const f32x4 v = b + acc[ai][bj][m][n] * scale;
                        *(f32x4*)(out + (size_t)grow * 1024 + c) = v;
                        if (xb) { u32x2v w; w.x = pk2(v[0], v[1]); w.y = pk2(v[2], v[3]); *(u32x2v*)(xb + (size_t)grow * 1024 + c) = w; }
                        ss += (v[0] * v[0] + v[1] * v[1]) + (v[2] * v[2] + v[3] * v[3]); }
                ss += __shfl_xor(ss, 16); ss += __shfl_xor(ss, 32);
                if (fq == 0) ssq[(size_t)grow * 16 + u.pn * 4 + wc] = ss;
                if (m & 1) asm volatile("" ::: "memory"); }
    }
};
struct EpiRowScale { static constexpr bool PERM = true, RSTD = true; const float* ssq; bf16_t* O; int ldc;
    __device__ __forceinline__ void operator()(const f32x4 (&acc)[2][2][4][2], const Unit& u, int wr, int wc, int fr, int fq, const PG8_LAS float* tab) const {
        const int col0 = u.pn * BM + wc * 32 + 8 * fq;
#pragma unroll
        for (int ai = 0; ai < 2; ++ai)
#pragma unroll
            for (int m = 0; m < 4; ++m) { const int lr = ai * HALF + wr * 64 + m * 16 + fr; const float rs = tab[lr];
                bf16_t* rowp = O + (size_t)(u.pm * BM + lr) * ldc + col0;
#pragma unroll
                for (int bj = 0; bj < 2; ++bj) *(u32x4*)(rowp + bj * HALF) = pk8(acc[ai][bj][m][0] * rs, acc[ai][bj][m][1] * rs); }
    }
};
__device__ __forceinline__ void rope8(f32x4& v0, f32x4& v1, int fq, const float* rp) {
    f32x4 o0, o1;
#pragma unroll
    for (int e = 0; e < 4; ++e) { o0[e] = __shfl_xor(v0[e], 16); o1[e] = __shfl_xor(v1[e], 16); }
    if (fq < 2) { const f32x4 c0 = *(const f32x4*)rp, c1 = *(const f32x4*)(rp + 4), s0 = *(const f32x4*)(rp + 8), s1 = *(const f32x4*)(rp + 12);
        const float sg = fq == 0 ? -1.f : 1.f; v0 = v0 * c0 + (o0 * s0) * sg; v1 = v1 * c1 + (o1 * s1) * sg; }
}
__device__ __forceinline__ int pos_index(int grow) { return grow < MPROWS ? (grow & 2047) : 2048 + ((grow - MPROWS) & 3); }
struct EpiInB { static constexpr bool PERM = true, RSTD = true; const float* ssq; bf16_t* O; const float* rope;
    __device__ __forceinline__ void operator()(const f32x4 (&acc)[2][2][4][2], const Unit& u, int wr, int wc, int fr, int fq, const PG8_LAS float* tab) const {
        const int col0 = u.pn * BM + wc * 32 + 8 * fq; const bool rot = (u.pn < 3) && ((wc & 1) == 0);
#pragma unroll
        for (int ai = 0; ai < 2; ++ai)
#pragma unroll
            for (int m = 0; m < 4; ++m) { const int lr = ai * HALF + wr * 64 + m * 16 + fr, grow = u.pm * BM + lr; const float rs = tab[lr];
                bf16_t* rowp = O + (size_t)grow * 1024 + col0; const float* rp = rope + pos_index(grow) * 16;
#pragma unroll
                for (int bj = 0; bj < 2; ++bj) { f32x4 v0 = acc[ai][bj][m][0] * rs, v1 = acc[ai][bj][m][1] * rs; if (rot) rope8(v0, v1, fq, rp); *(u32x4*)(rowp + bj * HALF) = pk8(v0, v1); } }
    }
};
struct EpiKV { static constexpr bool PERM = true, RSTD = true; const float* ssq; bf16_t* KVB; const float* rope; float* okp; float* ovp; float* oks; float* ovs;
    __device__ __forceinline__ void operator()(const f32x4 (&acc)[2][2][4][2], const Unit& u, int wr, int wc, int fr, int fq, const PG8_LAS float* tab) const {
#pragma unroll
        for (int bj = 0; bj < 2; ++bj) { const int wcol = u.pn * BM + bj * HALF + wc * 32; if (wcol >= 384) continue;
            const bool isk = wcol < 192, rot = isk && ((wc & 1) == 0); const int c0 = wcol + 8 * fq, cc = isk ? c0 : c0 - 192;
#pragma unroll
            for (int ai = 0; ai < 2; ++ai)
#pragma unroll
                for (int m = 0; m < 4; ++m) { const int lr = ai * HALF + wr * 64 + m * 16 + fr, grow = u.pm * BM + lr; const float rs = tab[lr];
                    f32x4 v0 = acc[ai][bj][m][0] * rs, v1 = acc[ai][bj][m][1] * rs; if (rot) rope8(v0, v1, fq, rope + pos_index(grow) * 16);
                    *(u32x4*)(KVB + (size_t)grow * 384 + c0) = pk8(v0, v1);
                    float* dst = nullptr;
                    if (grow < MPROWS) { const int t = grow & 2047; if (t >= 1920) dst = (isk ? okp : ovp) + (size_t)((grow >> 11) * 128 + t - 1920) * 192 + cc; }
                    else { const int r2 = grow - MPROWS; dst = (isk ? oks : ovs) + (size_t)((r2 >> 2) * 128 + 124 + (r2 & 3)) * 192 + cc; }
                    if (dst) { *(f32x4*)dst = v0; *(f32x4*)(dst + 4) = v1; } } }
    }
};
struct EpiMemKV { static constexpr bool PERM = true, RSTD = true; const float* ssq; bf16_t* MKV; float* okm; float* ovm;
    __device__ __forceinline__ void operator()(const f32x4 (&acc)[2][2][4][2], const Unit& u, int wr, int wc, int fr, int fq, const PG8_LAS float* tab) const {
        const int l = u.pn >> 1; float* ob = (u.pn & 1) ? ovm : okm;
#pragma unroll
        for (int ai = 0; ai < 2; ++ai)
#pragma unroll
            for (int m = 0; m < 4; ++m) { const int lr = ai * HALF + wr * 64 + m * 16 + fr, grow = u.pm * BM + lr; const float rs = tab[lr];
#pragma unroll
                for (int bj = 0; bj < 2; ++bj) { const int hd = bj * HALF + wc * 32 + 8 * fq; const f32x4 v0 = acc[ai][bj][m][0] * rs, v1 = acc[ai][bj][m][1] * rs;
                    float* dst = ob + (size_t)(l * 2048 + grow) * 256 + hd; *(f32x4*)dst = v0; *(f32x4*)(dst + 4) = v1;
                    *(u32x4*)(MKV + (size_t)grow * 1024 + u.pn * BM + hd) = pk8(v0, v1); } }
    }
};
__device__ __forceinline__ void prep_rstd(const float* ssq, const Unit& u, PG8_LAS float* tab, int tid) {
    const float* p = ssq + ((size_t)(u.pm * BM + (tid >> 1)) * 16 + (tid & 1) * 8);
    const f32x4 a = *(const f32x4*)p, b = *(const f32x4*)(p + 4);
    float s = ((a[0] + a[1]) + (a[2] + a[3])) + ((b[0] + b[1]) + (b[2] + b[3]));
    s += __shfl_xor(s, 1);
    if (!(tid & 1)) tab[tid >> 1] = 1.0f / sqrtf(s * (1.0f / 1024.0f) + 1e-6f);
}
template <class Epi, class Sched, bool ALIGN_EPI = false, bool SP2 = false>
__device__ __forceinline__ void gemm_phase(PG8_LAS unsigned char* lds, const Gemm g, const Sched& S, const Epi& E) {
    const int tid = threadIdx.x, wid = __builtin_amdgcn_readfirstlane(tid >> 6), lane = tid & 63, wr = wid >> 2, wc = wid & 3, fr = lane & 15, fq = lane >> 4;
    const int K = g.K, nt = K / BK;
    unsigned voffA[2], voffB[2];
#pragma unroll
    for (int i = 0; i < 2; ++i) { int R, C; stage_rc(tid * 16 + i * 8192, R, C); const int Rb = Epi::PERM ? ((R & ~31) + perm32(R & 31)) : R;
        voffA[i] = (unsigned)(R * K + C) * 2u; voffB[i] = (unsigned)(Rb * K + C) * 2u; }
    const size_t kstep = (size_t)(BK * 2);
    const size_t hstep = (size_t)HALF * K * 2;
    const size_t tstep = 2 * hstep;
    const unsigned ldsw = (unsigned)wid * 1024u;
    const int aoff = lds_byte(wr * 64 + fr, fq * 8), boff = lds_byte(wc * 32 + fr, fq * 8);
#define PG8_SA(b, h) (((b) * 2 + (h)) * HTB)
#define PG8_SB(b, h) ((4 + (b) * 2 + (h)) * HTB)
#define PG8_STAGE(bufoff, gbase, voff) do { _Pragma("unroll") for (int _i = 0; _i < 2; ++_i) \
        __builtin_amdgcn_global_load_lds((const unsigned*)((const char*)(gbase) + (voff)[_i]), (PG8_LAS unsigned*)(lds + (bufoff) + ldsw + _i * 8192), 16, 0, 0); } while (0)
#define PG8_LDA(dst, b, h) do { _Pragma("unroll") for (int m = 0; m < 4; ++m) _Pragma("unroll") for (int k = 0; k < 2; ++k) dst[m][k] = *(const PG8_LAS bf16x8*)(lds + PG8_SA(b, h) + aoff + m * 2048 + k * 1024); } while (0)
#define PG8_LDB(dst, b, h) do { _Pragma("unroll") for (int n = 0; n < 2; ++n) _Pragma("unroll") for (int k = 0; k < 2; ++k) dst[n][k] = *(const PG8_LAS bf16x8*)(lds + PG8_SB(b, h) + boff + n * 2048 + k * 1024); } while (0)
#define PG8_MMA(ai, bj, At, Bt) do { __builtin_amdgcn_s_setprio(1); _Pragma("unroll") for (int m = 0; m < 4; ++m) _Pragma("unroll") for (int n = 0; n < 2; ++n) _Pragma("unroll") for (int k = 0; k < 2; ++k) \
        acc[ai][bj][m][n] = __builtin_amdgcn_mfma_f32_16x16x32_bf16(Bt[n][k], At[m][k], acc[ai][bj][m][n], 0, 0, 0); __builtin_amdgcn_s_setprio(0); } while (0)
#define PG8_WAIT_V(n) asm volatile("s_waitcnt vmcnt(" #n ")" ::: "memory")
#define PG8_WAIT_L(n) asm volatile("s_waitcnt lgkmcnt(" #n ")" ::: "memory")
#define PG8_BAR __builtin_amdgcn_s_barrier()
#define PG8_SCHED __builtin_amdgcn_sched_barrier(0)
    Unit cur, nxt; int ui = 0;
    if (!S.next(0, cur)) return;
    PG8_LAS float* const tabs = (PG8_LAS float*)(lds + STAGE_BYTES);
    if constexpr (Epi::RSTD) prep_rstd(E.ssq, cur, tabs, tid);
    f32x4 acc[2][2][4][2];
#pragma unroll
    for (int a = 0; a < 2; ++a)
#pragma unroll
        for (int b = 0; b < 2; ++b)
#pragma unroll
            for (int m = 0; m < 4; ++m)
#pragma unroll
                for (int n = 0; n < 2; ++n) acc[a][b][m][n] = (f32x4){0.f, 0.f, 0.f, 0.f};
    bf16x8 At[4][2], B0[2][2], B1[2][2];
    const char* cA = (const char*)g.A + (size_t)cur.pm * tstep; const char* cB = (const char*)g.Bt + (size_t)cur.pn * tstep;
    S.a_ready(cur);
    if constexpr (SP2) {
        PG8_STAGE(PG8_SB(0, 0), cB, voffB); PG8_STAGE(PG8_SB(0, 1), cB + hstep, voffB); PG8_STAGE(PG8_SA(0, 0), cA, voffA); PG8_STAGE(PG8_SA(0, 1), cA + hstep, voffA);
        if (wr == 1) PG8_BAR;
        PG8_WAIT_V(2); PG8_BAR;
        PG8_STAGE(PG8_SB(1, 0), cB + kstep, voffB); PG8_STAGE(PG8_SA(1, 0), cA + kstep, voffA); PG8_STAGE(PG8_SB(1, 1), cB + hstep + kstep, voffB);
        PG8_WAIT_V(6); PG8_BAR;
    } else {
        PG8_STAGE(PG8_SB(0, 0), cB, voffB); PG8_STAGE(PG8_SA(0, 0), cA, voffA); PG8_STAGE(PG8_SB(0, 1), cB + hstep, voffB); PG8_STAGE(PG8_SA(0, 1), cA + hstep, voffA);
        if (wr == 1) PG8_BAR;
        PG8_WAIT_V(4); PG8_BAR;
        PG8_STAGE(PG8_SB(1, 0), cB + kstep, voffB); PG8_STAGE(PG8_SA(1, 0), cA + kstep, voffA); PG8_STAGE(PG8_SB(1, 1), cB + hstep + kstep, voffB);
        PG8_WAIT_V(6); PG8_BAR;
    }
    for (;;) {
        const bool has_next = S.next(ui + 1, nxt);
        const char* nA = has_next ? (const char*)g.A + (size_t)nxt.pm * tstep : cA; const char* nB = has_next ? (const char*)g.Bt + (size_t)nxt.pn * tstep : cB;
        for (int t = 0; t < nt; t += 2) {
            const bool last = (t == nt - 2);
            const char* a1 = cA + (size_t)(t + 1) * kstep;
            const char* a2 = last ? nA : cA + (size_t)(t + 2) * kstep; const char* b2 = last ? nB : cB + (size_t)(t + 2) * kstep;
            const char* a3 = a2 + kstep; const char* b3 = b2 + kstep;
            if (last && has_next) S.a_ready(nxt);
            if constexpr (SP2) {
            PG8_LDB(B0, 0, 0); PG8_LDB(B1, 0, 1); PG8_SCHED; PG8_LDA(At, 0, 0); PG8_STAGE(PG8_SA(1, 1), a1 + hstep, voffA);
            PG8_WAIT_V(8); PG8_WAIT_L(0); PG8_BAR; PG8_MMA(0, 0, At, B0); PG8_MMA(0, 1, At, B1); PG8_BAR; PG8_SCHED;
            PG8_LDA(At, 0, 1); PG8_STAGE(PG8_SB(0, 0), b2, voffB); PG8_STAGE(PG8_SB(0, 1), b2 + hstep, voffB); PG8_STAGE(PG8_SA(0, 0), a2, voffA);
            PG8_WAIT_V(8); PG8_WAIT_L(0); PG8_BAR; PG8_MMA(1, 0, At, B0); PG8_MMA(1, 1, At, B1); PG8_BAR; PG8_SCHED;
            PG8_LDB(B0, 1, 0); PG8_LDB(B1, 1, 1); PG8_SCHED; PG8_LDA(At, 1, 0); PG8_STAGE(PG8_SA(0, 1), a2 + hstep, voffA);
            PG8_WAIT_V(8); PG8_WAIT_L(0); PG8_BAR; PG8_MMA(0, 0, At, B0); PG8_MMA(0, 1, At, B1); PG8_BAR; PG8_SCHED;
            PG8_LDA(At, 1, 1); PG8_STAGE(PG8_SB(1, 0), b3, voffB); PG8_STAGE(PG8_SB(1, 1), b3 + hstep, voffB); PG8_STAGE(PG8_SA(1, 0), a3, voffA);
            PG8_WAIT_V(8); PG8_WAIT_L(0); PG8_BAR; PG8_MMA(1, 0, At, B0); PG8_MMA(1, 1, At, B1); PG8_BAR; PG8_SCHED;
            } else {
            PG8_LDB(B0, 0, 0); PG8_SCHED; PG8_LDA(At, 0, 0); PG8_STAGE(PG8_SA(1, 1), a1 + hstep, voffA);
            PG8_WAIT_L(8); PG8_BAR; PG8_WAIT_L(0); PG8_MMA(0, 0, At, B0); PG8_BAR; PG8_SCHED;
            PG8_LDB(B1, 0, 1); PG8_STAGE(PG8_SB(0, 0), b2, voffB);
            PG8_BAR; PG8_WAIT_L(0); PG8_MMA(0, 1, At, B1); PG8_BAR;
            PG8_LDA(At, 0, 1); PG8_STAGE(PG8_SA(0, 0), a2, voffA);
            PG8_BAR; PG8_WAIT_L(0); PG8_MMA(1, 0, At, B0); PG8_BAR; PG8_SCHED;
            PG8_STAGE(PG8_SB(0, 1), b2 + hstep, voffB);
            PG8_WAIT_V(6); PG8_BAR; PG8_MMA(1, 1, At, B1); PG8_BAR;
            PG8_LDB(B0, 1, 0); PG8_SCHED; PG8_LDA(At, 1, 0); PG8_STAGE(PG8_SA(0, 1), a2 + hstep, voffA);
            PG8_WAIT_L(8); PG8_BAR; PG8_WAIT_L(0); PG8_MMA(0, 0, At, B0); PG8_BAR; PG8_SCHED;
            PG8_LDB(B1, 1, 1); PG8_STAGE(PG8_SB(1, 0), b3, voffB);
            PG8_BAR; PG8_WAIT_L(0); PG8_MMA(0, 1, At, B1); PG8_BAR;
            PG8_LDA(At, 1, 1); PG8_STAGE(PG8_SA(1, 0), a3, voffA);
            PG8_BAR; PG8_WAIT_L(0); PG8_MMA(1, 0, At, B0); PG8_BAR; PG8_SCHED;
            PG8_STAGE(PG8_SB(1, 1), b3 + hstep, voffB);
            PG8_WAIT_V(6); PG8_BAR; PG8_MMA(1, 1, At, B1); PG8_BAR;
            }
        }
        if constexpr (ALIGN_EPI) { if (wr == 0) PG8_BAR; }
        E(acc, cur, wr, wc, fr, fq, tabs + (ui & 1) * 256);
        if constexpr (Epi::RSTD) { if (has_next) prep_rstd(E.ssq, nxt, tabs + ((ui + 1) & 1) * 256, tid); }
        if (!has_next) break;
#pragma unroll
        for (int a = 0; a < 2; ++a)
#pragma unroll
            for (int b = 0; b < 2; ++b)
#pragma unroll
                for (int m = 0; m < 4; ++m)
#pragma unroll
                    for (int n = 0; n < 2; ++n) acc[a][b][m][n] = (f32x4){0.f, 0.f, 0.f, 0.f};
        cur = nxt; cA = nA; cB = nB; ++ui;
        if constexpr (ALIGN_EPI) { if (wr == 1) PG8_BAR; }
    }
    PG8_WAIT_V(0);
    if constexpr (!ALIGN_EPI) { if (wr == 0) PG8_BAR; }
    PG8_BAR;
#undef PG8_SA
#undef PG8_SB
#undef PG8_STAGE
#undef PG8_LDA
#undef PG8_LDB
#undef PG8_MMA
#undef PG8_WAIT_V
#undef PG8_WAIT_L
#undef PG8_BAR
#undef PG8_SCHED
}
}

using pg8::bf16x8; using pg8::f32x4; using pg8::u32x4; using pg8::pk2; using pg8::pk8; using pg8::silu_f;
typedef unsigned short bf16;
#define LAS __attribute__((address_space(3)))
#define DI __device__ __forceinline__
typedef unsigned v4u __attribute__((ext_vector_type(4)));
typedef unsigned v2u __attribute__((ext_vector_type(2)));
typedef float f32x16 __attribute__((ext_vector_type(16)));
typedef short s16x4 __attribute__((ext_vector_type(4)));
#define RLX_AGENT __ATOMIC_RELAXED, __HIP_MEMORY_SCOPE_AGENT

constexpr int DM = 1024, MP = 16384, MS = 512, MT = MP + MS, SEQL = 2048, FF = 2816, NGU = 5632, AINW = 2816;
constexpr float C2 = 0.18033688011112042f;
constexpr float LOG2E = 1.4426950408889634f;
constexpr size_t MiB = 1u << 20;
constexpr size_t WS_CTL = 0, CTL_ZERO_BYTES = 64 * 1024;
constexpr size_t WS_ROPE = 1 * MiB;
constexpr size_t WS_SSQ = WS_ROPE + 256 * 1024;
constexpr size_t WS_SSQM = WS_SSQ + 1280 * 1024;
constexpr size_t WS_GDV = WS_SSQM + 256 * 1024;
constexpr size_t WS_WGU = 4 * MiB;
constexpr size_t WS_WD = WS_WGU + 48 * MiB;
constexpr size_t WS_WAIN = WS_WD + 22 * MiB;
constexpr size_t WS_WAOUT = WS_WAIN + 5632 * 1024;
constexpr size_t WS_WBIN = WS_WAOUT + 2 * MiB;
constexpr size_t WS_WBOUT = WS_WBIN + 2 * MiB;
constexpr size_t WS_WKV = WS_WBOUT + 2 * MiB;
constexpr size_t WS_WMKV = WS_WKV + 1 * MiB;
constexpr size_t WS_XB = WS_WMKV + 2 * MiB;
constexpr size_t WS_MPB = WS_XB + 33 * MiB;
constexpr size_t WS_MKV = WS_MPB + 4 * MiB;
constexpr size_t WS_BIG = WS_MKV + 4 * MiB;
constexpr size_t WS_MIX = WS_BIG + 91 * MiB;
constexpr size_t WS_KVB = WS_MIX + 33 * MiB;
constexpr size_t WS_UT = WS_KVB + 13 * MiB;
constexpr size_t WS_END = WS_UT + 72 * MiB;
constexpr int LDS_BYTES = 147456, MISC_OFF = LDS_BYTES - 512;

DI float bflo(unsigned w) { return __uint_as_float(w << 16); }
DI float bfhi(unsigned w) { return __uint_as_float(w & 0xffff0000u); }
DI float bf2f(unsigned short h) { return __uint_as_float((unsigned)h << 16); }
DI unsigned short f2bf(float f) { return (unsigned short)(pk2(f, 0.f) & 0xffffu); }
DI float wave_sum(float v) {
#pragma unroll
    for (int o = 1; o < 64; o <<= 1) v += __shfl_xor(v, o);
    return v;
}
#define XB_TMO      128
#define XB_XCNT(j)  (256  + 64 * (j))
#define XB_XSUB(j)  (1280 + 64 * (j))
#define XB_XGEN(j)  (2304 + 64 * (j))
#define XB_TOP      3328
#define XB_TOPGEN   3392
#define XCD_BAR_WORDS 3456
#define XB_SPIN_CAP (1u << 18)

__device__ __forceinline__ unsigned xb_ld(unsigned* p)              { return __hip_atomic_load(p, __ATOMIC_RELAXED, __HIP_MEMORY_SCOPE_AGENT); }
__device__ __forceinline__ unsigned xb_add(unsigned* p, unsigned v) { return __hip_atomic_fetch_add(p, v, __ATOMIC_RELAXED, __HIP_MEMORY_SCOPE_AGENT); }
__device__ __forceinline__ unsigned xb_xcc_id() { return (unsigned)__builtin_amdgcn_s_getreg((3 << 11) | 20) & 0xFu; }
#define XB_SPIN(cond, bar) do { unsigned _sp = 0; while (cond) { __builtin_amdgcn_s_sleep(1); \
    if ((++_sp & 255u) == 0u) { if (xb_ld(&(bar)[XB_TMO])) break; if (_sp > XB_SPIN_CAP) { atomicAdd(&(bar)[XB_TMO], 1u); break; } } } } while (0)

struct XcdBarrier {
    unsigned* bar; unsigned x;
    volatile LAS unsigned* st;
};

__device__ __forceinline__ XcdBarrier xcd_barrier_post(unsigned* bar, volatile LAS unsigned* st) {
    XcdBarrier b; b.bar = bar; b.x = xb_xcc_id(); b.st = st;
    if (threadIdx.x == 0) (void)xb_add(&bar[XB_XCNT(b.x)], 1u);
    return b;
}
__device__ __forceinline__ void xcd_barrier_complete(unsigned* bar, unsigned x, unsigned& nloc, unsigned& nx) {
    const unsigned G = gridDim.x * gridDim.y * gridDim.z;
    unsigned sum, cnt, mine, sp = 0u;
    for (;;) {
        sum = 0u; cnt = 0u; mine = 0u;
#pragma unroll
        for (unsigned j = 0; j < 16; ++j) { const unsigned c = xb_ld(&bar[XB_XCNT(j)]); sum += c; cnt += (c > 0u) ? 1u : 0u; mine = (j == x) ? c : mine; }
        if (sum == G) break;
        __builtin_amdgcn_s_sleep(1);
        if ((++sp & 255u) == 0u) { if (xb_ld(&bar[XB_TMO])) break; if (sp > XB_SPIN_CAP) { atomicAdd(&bar[XB_TMO], 1u); break; } }
    }
    nloc = mine > 0u ? mine : 1u; nx = cnt > 0u ? cnt : 1u;
}

__device__ __forceinline__ void xcd_barrier(const XcdBarrier& b) {
    asm volatile("s_waitcnt vmcnt(0)" ::: "memory");
    __syncthreads();
    if (threadIdx.x == 0) {
        unsigned* bar = b.bar;
        __builtin_amdgcn_s_waitcnt(0);
        unsigned nloc = b.st[0], nx = b.st[1];
        if (nloc == 0u) { xcd_barrier_complete(bar, b.x, nloc, nx); b.st[0] = nloc; b.st[1] = nx; }
        const unsigned old = xb_add(&bar[XB_XSUB(b.x)], 1u);
        const unsigned gen = old / nloc;
        if (old + 1u == (gen + 1u) * nloc) {
            __builtin_amdgcn_fence(__ATOMIC_RELEASE, "agent");
            asm volatile("s_waitcnt vmcnt(0)" ::: "memory");
            const unsigned og = xb_add(&bar[XB_TOP], 1u);
            const unsigned tg = og / nx;
            if (og + 1u == (tg + 1u) * nx) xb_add(&bar[XB_TOPGEN], 1u);
            else XB_SPIN(xb_ld(&bar[XB_TOPGEN]) == tg, bar);
            __builtin_amdgcn_fence(__ATOMIC_ACQUIRE, "agent");
            xb_add(&bar[XB_XGEN(b.x)], 1u);
            asm volatile("s_waitcnt vmcnt(0)" ::: "memory");
        } else {
            XB_SPIN(xb_ld(&bar[XB_XGEN(b.x)]) == gen, bar);
            __builtin_amdgcn_fence(__ATOMIC_ACQUIRE, "agent");
            asm volatile("s_waitcnt vmcnt(0)" ::: "memory");
        }
    }
    __syncthreads();
}

enum { TK_ID = 0, TK_GU = 1, TK_AIN = 2, TK_BIN = 3, TK_KV = 4 };
struct TJob { const float* W; const float* gain; bf16* WT; int K, N, nd, kind; };
DI void map_row(int kind, int n, int& src, float& sc) {
    src = n; sc = 1.f;
    if (kind == TK_GU) { const int t = n >> 8, w = n & 255; src = (w < 128) ? 128 * t + w : 2816 + 128 * t + (w - 128); }
    else if (kind == TK_AIN) {
        if (n < 384) sc = 0.10206207261596575f;
        else if (n < 2304) {}
        else if (n < 2560) { src = 2320 + (n - 2304); sc = C2; }
        else if (n < 2576) src = 2304 + (n - 2560);
        else src = -1; }
    else if (kind == TK_BIN) sc = C2;
    else if (kind == TK_KV) { if (n >= 384) src = -1; }
}
DI void p0_transpose_item(const TJob& J, LAS float* scr, int item, int lane) {
    const int nblk = J.nd / 32, kb = item / nblk, nb = item % nblk, k0 = 64 * kb, n0 = 32 * nb;
    int src; float sc; map_row(J.kind, n0 + (lane & 31), src, sc);
#pragma unroll 8
    for (int i = 0; i < 32; ++i) { const int kk = 2 * i + (lane >> 5); float v = 0.f;
        if (src >= 0) { v = J.W[(size_t)(k0 + kk) * J.N + src] * sc; if (J.gain) v *= J.gain[k0 + kk]; }
        scr[kk * 33 + (lane & 31)] = v; }
    asm volatile("s_waitcnt lgkmcnt(0)" ::: "memory");
    const int c = lane & 7;
#pragma unroll
    for (int j = 0; j < 4; ++j) { const int n = (lane >> 3) + 8 * j; const LAS float* s = scr + (8 * c) * 33 + n;
        v4u o; o.x = pk2(s[0 * 33], s[1 * 33]); o.y = pk2(s[2 * 33], s[3 * 33]); o.z = pk2(s[4 * 33], s[5 * 33]); o.w = pk2(s[6 * 33], s[7 * 33]);
        *(v4u*)(J.WT + (size_t)(n0 + n) * J.K + k0 + 8 * c) = o; }
    asm volatile("s_waitcnt lgkmcnt(0)" ::: "memory");
}
DI void row_to_bf16(const float* xrow, bf16* orow, float* ssqrow, int lane) {
    const f32x4* xr = (const f32x4*)xrow + lane; f32x4 v[4]; float s = 0.f;
#pragma unroll
    for (int j = 0; j < 4; ++j) { v[j] = xr[64 * j]; s += (v[j][0] * v[j][0] + v[j][1] * v[j][1]) + (v[j][2] * v[j][2] + v[j][3] * v[j][3]); }
    s = wave_sum(s);
    v2u* o8 = (v2u*)orow + lane;
#pragma unroll
    for (int j = 0; j < 4; ++j) { v2u w; w.x = pk2(v[j][0], v[j][1]); w.y = pk2(v[j][2], v[j][3]); o8[64 * j] = w; }
    if (lane < 16) ssqrow[lane] = lane == 0 ? s : 0.f;
}
DI void rope_entry(float* rope, int idx) {
    const int p = idx >> 3, i = idx & 7;
    const double pos = p < 2048 ? (double)p : (double)(8192 + (p - 2048));
    const double inv = i == 0 ? 1.0 : i == 1 ? 0.1939227447486858 : i == 2 ? 0.03760603093086394 : i == 3 ? 0.007292664737217109 : i == 4 ? 0.0014142135623730955
                     : i == 5 ? 0.00027424817567620724 : i == 6 ? 5.318295896944988e-05 : 1.0313385377212461e-05;
    const double ang = pos * inv, n = __builtin_rint(ang * 0.15915494309189535), r = (ang - n * 6.283185307179586) - n * 2.4492935982947064e-16, r2 = r * r;
    double s = 1.0, c = 1.0;
#pragma unroll
    for (int k = 14; k >= 1; --k) { s = 1.0 - r2 * s * (1.0 / (double)((2 * k) * (2 * k + 1))); c = 1.0 - r2 * c * (1.0 / (double)((2 * k - 1) * (2 * k))); }
    rope[p * 16 + i] = (float)c; rope[p * 16 + 8 + i] = (float)(r * s);
}

constexpr int ATT_V = 36864;
struct KVSrc { const float* kf; const float* vf; long stridef; int nf;
               const bf16* kb; const bf16* vb; long strideb; int blo, bhi; };
template <int NKT> DI void attn_stage(LAS unsigned char* lds, const KVSrc& s, int tid) {
    const int key = tid >> 1, half = tid & 1;
    if (key < NKT * 32) {
        v4u kq[4], vq[4];
        if (key < s.nf) { const float* kp = s.kf + (long)key * s.stridef + half * 32; const float* vp = s.vf + (long)key * s.stridef + half * 32;
#pragma unroll
            for (int j = 0; j < 4; ++j) { kq[j] = pk8(*(const f32x4*)(kp + 8 * j), *(const f32x4*)(kp + 8 * j + 4)); vq[j] = pk8(*(const f32x4*)(vp + 8 * j), *(const f32x4*)(vp + 8 * j + 4)); } }
        else if (key >= s.blo && key < s.bhi) { const bf16* kp = s.kb + (long)key * s.strideb + half * 32; const bf16* vp = s.vb + (long)key * s.strideb + half * 32;
#pragma unroll
            for (int j = 0; j < 4; ++j) { kq[j] = *(const v4u*)(kp + 8 * j); vq[j] = *(const v4u*)(vp + 8 * j); } }
        else {
#pragma unroll
            for (int j = 0; j < 4; ++j) { kq[j] = (v4u){0u, 0u, 0u, 0u}; vq[j] = (v4u){0u, 0u, 0u, 0u}; } }
#pragma unroll
        for (int j = 0; j < 4; ++j) *(LAS v4u*)(lds + key * 144 + half * 64 + j * 16) = kq[j];
#pragma unroll
        for (int j = 0; j < 4; ++j)
#pragma unroll
            for (int w = 0; w < 4; ++w) { const unsigned word = vq[j][w]; const int d = half * 32 + j * 8 + 2 * w;
                *(LAS unsigned short*)(lds + ATT_V + d * 520 + key * 2) = (unsigned short)(word & 0xffffu);
                *(LAS unsigned short*)(lds + ATT_V + (d + 1) * 520 + key * 2) = (unsigned short)(word >> 16); }
    }
}
template <int NKT, bool SINK> DI void attn_core(const LAS unsigned char* lds, const bf16x8 (&qf)[4], int lo, int hi, float sink2, f32x16 (&o)[2], int lane, int t0) {
    const int r = lane & 31, hh = lane >> 5;
    f32x16 st[NKT];
#pragma unroll
    for (int t = 0; t < NKT; ++t) {
#pragma unroll
        for (int i = 0; i < 16; ++i) st[t][i] = 0.f;
#pragma unroll
        for (int d0 = 0; d0 < 4; ++d0) { const bf16x8 kf = *(const LAS bf16x8*)(lds + (32 * (t0 + t) + r) * 144 + (d0 * 16 + 8 * hh) * 2);
            st[t] = __builtin_amdgcn_mfma_f32_32x32x16_bf16(kf, qf[d0], st[t], 0, 0, 0); } }
    float m = -INFINITY;
#pragma unroll
    for (int t = 0; t < NKT; ++t)
#pragma unroll
        for (int i = 0; i < 16; ++i) { const int s = 32 * (t0 + t) + (i & 3) + 8 * (i >> 2) + 4 * hh; const float v = (s >= lo && s <= hi) ? st[t][i] : -INFINITY; st[t][i] = v; m = fmaxf(m, v); }
    m = fmaxf(m, __shfl_xor(m, 32));
    if (SINK) m = fmaxf(m, sink2);
    if (m == -INFINITY) m = 0.f;
    float l = 0.f;
#pragma unroll
    for (int t = 0; t < NKT; ++t)
#pragma unroll
        for (int i = 0; i < 16; ++i) { const float p = __builtin_amdgcn_exp2f(st[t][i] - m); st[t][i] = p; l += p; }
    l += __shfl_xor(l, 32);
    if (SINK) l += __builtin_amdgcn_exp2f(sink2 - m);
#pragma unroll
    for (int i = 0; i < 16; ++i) { o[0][i] = 0.f; o[1][i] = 0.f; }
#pragma unroll
    for (int t = 0; t < NKT; ++t)
#pragma unroll
        for (int s2 = 0; s2 < 2; ++s2) {
            v4u pw; pw.x = pk2(st[t][8 * s2 + 0], st[t][8 * s2 + 1]); pw.y = pk2(st[t][8 * s2 + 2], st[t][8 * s2 + 3]); pw.z = pk2(st[t][8 * s2 + 4], st[t][8 * s2 + 5]); pw.w = pk2(st[t][8 * s2 + 6], st[t][8 * s2 + 7]);
            const bf16x8 pb = __builtin_bit_cast(bf16x8, pw);
#pragma unroll
            for (int dt = 0; dt < 2; ++dt) { const LAS unsigned char* vp = lds + ATT_V + (32 * dt + r) * 520 + (32 * (t0 + t) + 16 * s2 + 4 * hh) * 2;
                const s16x4 lo4 = *(const LAS s16x4*)vp, hi4 = *(const LAS s16x4*)(vp + 16);
                const bf16x8 va = __builtin_shufflevector(lo4, hi4, 0, 1, 2, 3, 4, 5, 6, 7);
                o[dt] = __builtin_amdgcn_mfma_f32_32x32x16_bf16(va, pb, o[dt], 0, 0, 0); } }
    const float inv = 1.0f / l;
#pragma unroll
    for (int i = 0; i < 16; ++i) { o[0][i] *= inv; o[1][i] *= inv; }
}
template <int NKT, bool SINK> DI void attn_wave(const LAS unsigned char* lds, const bf16* qptr, int lo, int hi, float sink2, bf16* optr, bool valid, int lane, int t0 = 0) {
    const int hh = lane >> 5; bf16x8 qf[4];
#pragma unroll
    for (int d0 = 0; d0 < 4; ++d0) qf[d0] = *(const bf16x8*)(qptr + d0 * 16 + 8 * hh);
    f32x16 o[2]; attn_core<NKT, SINK>(lds, qf, lo, hi, sink2, o, lane, t0);
    if (valid) {
#pragma unroll
        for (int dt = 0; dt < 2; ++dt)
#pragma unroll
            for (int g = 0; g < 4; ++g) { v2u w; w.x = pk2(o[dt][4 * g], o[dt][4 * g + 1]); w.y = pk2(o[dt][4 * g + 2], o[dt][4 * g + 3]); *(v2u*)(optr + 32 * dt + 8 * g + 4 * hh) = w; } }
}

struct Ptrs {
    const float* in[28]; float* out; unsigned char* ws;
    float *o_y, *o_glap, *o_glas, *o_kp, *o_vp, *o_ks, *o_vs, *o_mk, *o_mv;
    float *rope, *ssq, *ssqm, *gdv, *ut; bf16 *xb, *mpb, *mkv, *big, *mix, *kvb;
};
DI void unit_mem_prompt(const Ptrs& P, LAS unsigned char* lds, int L, int u, int tid) {
    const int b = u >> 5, h = (u >> 3) & 3, qb = u & 7, lane = tid & 63, w = tid >> 6;
    KVSrc s; s.kf = nullptr; s.vf = nullptr; s.stridef = 0; s.nf = 0; s.kb = P.mkv + (size_t)(b * 256) * 1024 + L * 512 + h * 64; s.vb = s.kb + 256; s.strideb = 1024; s.blo = 0; s.bhi = 256;
    attn_stage<8>(lds, s, tid); __syncthreads();
    const int row = b * SEQL + qb * 256 + 32 * w + (lane & 31);
    const bf16* qptr = (L == 0) ? P.big + (size_t)row * AINW + 2304 + 64 * h : P.big + (size_t)row * 1024 + 768 + 64 * h;
    attn_wave<8, false>(lds, qptr, 0, 255, 0.f, P.mix + (size_t)row * 1024 + 768 + 64 * h, true, lane);
    __syncthreads();
}
DI void unit_mem_sample(const Ptrs& P, LAS unsigned char* lds, int L, int u, int tid) {
    const int b = u >> 2, h = u & 3, lane = tid & 63, w = tid >> 6;
    KVSrc s; const size_t off = ((size_t)((L * 128 + b) * 256) * 4 + h) * 64; s.kf = P.in[5] + off; s.vf = P.in[6] + off; s.stridef = 256; s.nf = 256; s.kb = nullptr; s.vb = nullptr; s.strideb = 0; s.blo = 0; s.bhi = 0;
    attn_stage<8>(lds, s, tid); __syncthreads();
    if (w == 0) { const int r = lane & 31, row = MP + 4 * b + (r & 3);
        const bf16* qptr = (L == 0) ? P.big + (size_t)row * AINW + 2304 + 64 * h : P.big + (size_t)row * 1024 + 768 + 64 * h;
        attn_wave<8, false>(lds, qptr, 0, 255, 0.f, P.mix + (size_t)row * 1024 + 768 + 64 * h, r < 4, lane); }
    __syncthreads();
}
DI void unit_swa_prompt(const Ptrs& P, LAS unsigned char* lds, int u, int tid) {
    const int b = u / 96, rem = u % 96, kvh = rem >> 5, nblk = (rem & 31) >> 1, gp = rem & 1, lane = tid & 63, w = tid >> 6;
    KVSrc s; s.kf = nullptr; s.vf = nullptr; s.stridef = 0; s.nf = 0; s.kb = P.kvb + ((long)(b * SEQL + (nblk - 1) * 128)) * 384 + kvh * 64; s.vb = s.kb + 192; s.strideb = 384; s.blo = nblk == 0 ? 128 : 0; s.bhi = 256;
    attn_stage<8>(lds, s, tid); __syncthreads();
    const int hq = kvh * 4 + gp * 2 + (w >> 2), qi = 32 * (w & 3) + (lane & 31), row = b * SEQL + nblk * 128 + qi;
    const int lo = (qi + 1 > s.blo) ? qi + 1 : s.blo;
    attn_wave<5, true>(lds, P.big + (size_t)row * 1024 + hq * 64, lo, qi + 128, P.in[25][hq] * LOG2E, P.mix + (size_t)row * 1024 + hq * 64, true, lane, w & 3);
    __syncthreads();
}
DI void unit_swa_sample(const Ptrs& P, LAS unsigned char* lds, int u, int tid) {
    const int b = u / 3, kvh = u % 3, lane = tid & 63, w = tid >> 6;
    KVSrc s; const size_t off = ((size_t)(b * 128) * 3 + kvh) * 64; s.kf = P.in[3] + off; s.vf = P.in[4] + off; s.stridef = 192; s.nf = 128;
    s.kb = P.kvb + ((long)(MP + 4 * b) - 128) * 384 + kvh * 64; s.vb = s.kb + 192; s.strideb = 384; s.blo = 128; s.bhi = 132;
    attn_stage<5>(lds, s, tid); __syncthreads();
    if (w == 0) { const int r = lane & 31, g = (r >> 2) & 3, qi = r & 3, hq = kvh * 4 + g, row = MP + 4 * b + qi;
        attn_wave<5, true>(lds, P.big + (size_t)row * 1024 + hq * 64, qi + 1, qi + 128, P.in[25][hq] * LOG2E, P.mix + (size_t)row * 1024 + hq * 64, r < 16, lane); }
    __syncthreads();
}

constexpr int GL_LA = 0, GL_QP = 24576, GL_KP = 37888, GL_G16 = 51200, GL_WG = 55296, GL_BG = 61440, GL_SEG = 61824, GL_VT = 63488, GL_ST = 91136, GL_AM = 131072;
DI float log_sig16(float z) { return (fminf(z, 0.f) - log1pf(expf(-fabsf(z)))) * 0.0625f; }
DI void gla_common(const Ptrs& P, LAS unsigned char* lds, int r0, int h, int tid) {
    LAS float* LA = (LAS float*)(lds + GL_LA); LAS float* G16 = (LAS float*)(lds + GL_G16); LAS float* WG = (LAS float*)(lds + GL_WG); LAS float* BG = (LAS float*)(lds + GL_BG); LAS float* SEG = (LAS float*)(lds + GL_SEG);
    if (tid < 256) { const int i = tid >> 2, q4 = tid & 3; const v2u w = *(const v2u*)(P.big + (size_t)(r0 + i) * AINW + 2560 + q4 * 4);
        LAS float* g = G16 + i * 16 + q4 * 4; g[0] = bflo(w.x); g[1] = bfhi(w.x); g[2] = bflo(w.y); g[3] = bfhi(w.y); }
    if (tid < 384) { const int idx = tid * 4, j = idx / 96, d = idx % 96; *(LAS f32x4*)(WG + j * 96 + d) = *(const f32x4*)(P.in[18] + j * 384 + 96 * h + d); }
    if (tid < 96) BG[tid] = P.in[19][96 * h + tid];
    __syncthreads();
#pragma unroll
    for (int k = 0; k < 12; ++k) { const int idx = tid + 512 * k, i = idx / 96, d = idx % 96; float z = BG[d];
#pragma unroll
        for (int j = 0; j < 16; ++j) z += G16[i * 16 + j] * WG[j * 96 + d];
        LA[i * 96 + d] = log_sig16(z); }
    __syncthreads();
    float loc[16]; const int d = tid % 96, sg = tid / 96;
    if (tid < 384) { float s = 0.f;
#pragma unroll
        for (int k = 0; k < 16; ++k) { s += LA[(sg * 16 + k) * 96 + d]; loc[k] = s; }
        SEG[sg * 96 + d] = s; }
    __syncthreads();
    if (tid < 384) { float off = 0.f;
#pragma unroll
        for (int s2 = 0; s2 < 3; ++s2) if (s2 < sg) off += SEG[s2 * 96 + d];
#pragma unroll
        for (int k = 0; k < 16; ++k) LA[(sg * 16 + k) * 96 + d] = loc[k] + off; }
    __syncthreads();
}
DI void gla_stage_vt(const Ptrs& P, LAS unsigned char* lds, int r0, int h, int tid) {
    const int j = tid >> 3, sg = tid & 7; const bf16* row = P.big + (size_t)(r0 + j) * AINW + 768 + 192 * h + sg * 24;
#pragma unroll
    for (int q = 0; q < 3; ++q) { const v4u w = *(const v4u*)(row + q * 8);
#pragma unroll
        for (int e = 0; e < 4; ++e) { const int vv = sg * 24 + q * 8 + 2 * e;
            *(LAS unsigned short*)(lds + GL_VT + vv * 144 + j * 2) = (unsigned short)(w[e] & 0xffffu);
            *(LAS unsigned short*)(lds + GL_VT + (vv + 1) * 144 + j * 2) = (unsigned short)(w[e] >> 16); } }
}
DI void unit_gla_pass1(const Ptrs& P, LAS unsigned char* lds, int unit, int tid) {
    const int b = unit >> 7, h = (unit >> 5) & 3, c = unit & 31, r0 = b * SEQL + 64 * c, lane = tid & 63, w = tid >> 6, fr = lane & 15, fq = lane >> 4;
    gla_common(P, lds, r0, h, tid);
    const LAS float* LA = (const LAS float*)(lds + GL_LA);
    { const int j = tid >> 3, sg = tid & 7; const bf16* row = P.big + (size_t)(r0 + j) * AINW + 384 + 96 * h + sg * 12;
#pragma unroll
        for (int q = 0; q < 3; ++q) { const v2u wv = *(const v2u*)(row + q * 4); const float kv[4] = {bflo(wv.x), bfhi(wv.x), bflo(wv.y), bfhi(wv.y)};
#pragma unroll
            for (int e = 0; e < 4; ++e) { const int d = sg * 12 + q * 4 + e; *(LAS unsigned short*)(lds + GL_QP + d * 144 + j * 2) = f2bf(kv[e] * expf(LA[63 * 96 + d] - LA[j * 96 + d])); } } }
    gla_stage_vt(P, lds, r0, h, tid);
    if (tid < 96) P.gdv[(size_t)unit * 96 + tid] = expf(LA[63 * 96 + tid]);
    __syncthreads();
    float* ut = P.ut + (size_t)unit * 18432;
#pragma unroll 1
    for (int k = 0; k < 9; ++k) { const int tile = w + 8 * k, tv = tile / 6, td = tile % 6; f32x4 acc = {0.f, 0.f, 0.f, 0.f};
#pragma unroll
        for (int ks = 0; ks < 2; ++ks) { const bf16x8 a = *(const LAS bf16x8*)(lds + GL_VT + (tv * 16 + fr) * 144 + (ks * 32 + fq * 8) * 2), bb = *(const LAS bf16x8*)(lds + GL_QP + (td * 16 + fr) * 144 + (ks * 32 + fq * 8) * 2);
            acc = __builtin_amdgcn_mfma_f32_16x16x32_bf16(a, bb, acc, 0, 0, 0); }
#pragma unroll
        for (int rg = 0; rg < 4; ++rg) ut[(tv * 16 + fq * 4 + rg) * 96 + td * 16 + fr] = acc[rg]; }
    __syncthreads();
}
DI void unit_gla_pass3(const Ptrs& P, LAS unsigned char* lds, int unit, int tid) {
    const int b = unit >> 7, h = (unit >> 5) & 3, c = unit & 31, r0 = b * SEQL + 64 * c, lane = tid & 63, w = tid >> 6, fr = lane & 15, fq = lane >> 4;
    gla_common(P, lds, r0, h, tid);
    const LAS float* LA = (const LAS float*)(lds + GL_LA);
    { const int j = tid >> 3, sg = tid & 7; const bf16* row = P.big + (size_t)(r0 + j) * AINW + 96 * h + sg * 12;
#pragma unroll
        for (int q = 0; q < 3; ++q) { const int d = sg * 12 + q * 4; const v2u wq = *(const v2u*)(row + q * 4), wk = *(const v2u*)(row + 384 + q * 4);
            const float e0 = expf(LA[j * 96 + d]), e1 = expf(LA[j * 96 + d + 1]), e2 = expf(LA[j * 96 + d + 2]), e3 = expf(LA[j * 96 + d + 3]);
            v2u oq, ok; oq.x = pk2(bflo(wq.x) * e0, bfhi(wq.x) * e1); oq.y = pk2(bflo(wq.y) * e2, bfhi(wq.y) * e3);
            ok.x = pk2(bflo(wk.x) / e0, bfhi(wk.x) / e1); ok.y = pk2(bflo(wk.y) / e2, bfhi(wk.y) / e3);
            *(LAS v2u*)(lds + GL_QP + (j * 104 + d) * 2) = oq; *(LAS v2u*)(lds + GL_KP + (j * 104 + d) * 2) = ok; } }
    gla_stage_vt(P, lds, r0, h, tid);
    { const float* st = P.ut + (size_t)unit * 18432;
#pragma unroll
        for (int k = 0; k < 9; ++k) { const int idx = tid + 512 * k, vv = idx / 24, d4 = (idx % 24) * 4; const f32x4 sv = *(const f32x4*)(st + (size_t)idx * 4);
            v2u o; o.x = pk2(sv[0], sv[1]); o.y = pk2(sv[2], sv[3]); *(LAS v2u*)(lds + GL_ST + (vv * 104 + d4) * 2) = o; } }
    __syncthreads();
#pragma unroll
    for (int k = 0; k < 2; ++k) { const int tile = 2 * w + k, ti = tile >> 2, tj = tile & 3; f32x4 acc = {0.f, 0.f, 0.f, 0.f};
        if (tj <= ti) {
#pragma unroll
            for (int ks = 0; ks < 3; ++ks) { const bf16x8 a = *(const LAS bf16x8*)(lds + GL_QP + ((ti * 16 + fr) * 104 + ks * 32 + fq * 8) * 2), bb = *(const LAS bf16x8*)(lds + GL_KP + ((tj * 16 + fr) * 104 + ks * 32 + fq * 8) * 2);
                acc = __builtin_amdgcn_mfma_f32_16x16x32_bf16(a, bb, acc, 0, 0, 0); } }
#pragma unroll
        for (int rg = 0; rg < 4; ++rg) { const int i = ti * 16 + fq * 4 + rg, j = tj * 16 + fr; *(LAS unsigned short*)(lds + GL_AM + (i * 72 + j) * 2) = f2bf((j <= i) ? acc[rg] : 0.f); } }
    __syncthreads();
    f32x4 oacc[6];
#pragma unroll
    for (int k = 0; k < 6; ++k) { const int tile = w + 8 * k, ti = tile & 3, tv = tile >> 2; f32x4 acc = {0.f, 0.f, 0.f, 0.f};
#pragma unroll
        for (int ks = 0; ks < 2; ++ks) { const bf16x8 a = *(const LAS bf16x8*)(lds + GL_AM + ((ti * 16 + fr) * 72 + ks * 32 + fq * 8) * 2), bb = *(const LAS bf16x8*)(lds + GL_VT + ((tv * 16 + fr) * 72 + ks * 32 + fq * 8) * 2);
            acc = __builtin_amdgcn_mfma_f32_16x16x32_bf16(a, bb, acc, 0, 0, 0); }
#pragma unroll
        for (int ks = 0; ks < 3; ++ks) { const bf16x8 a = *(const LAS bf16x8*)(lds + GL_QP + ((ti * 16 + fr) * 104 + ks * 32 + fq * 8) * 2), bb = *(const LAS bf16x8*)(lds + GL_ST + ((tv * 16 + fr) * 104 + ks * 32 + fq * 8) * 2);
            acc = __builtin_amdgcn_mfma_f32_16x16x32_bf16(a, bb, acc, 0, 0, 0); }
        oacc[k] = acc; }
    __syncthreads();
    LAS float* OB = (LAS float*)lds;
#pragma unroll
    for (int k = 0; k < 6; ++k) { const int tile = w + 8 * k, ti = tile & 3, tv = tile >> 2;
#pragma unroll
        for (int rg = 0; rg < 4; ++rg) OB[(ti * 16 + fq * 4 + rg) * 196 + tv * 16 + fr] = oacc[k][rg]; }
    __syncthreads();
    { const int i = tid >> 3, sg = tid & 7; f32x4 ov[6]; float ss = 0.f;
#pragma unroll
        for (int e = 0; e < 6; ++e) { ov[e] = *(const LAS f32x4*)(OB + i * 196 + sg * 24 + 4 * e); ss += (ov[e][0] * ov[e][0] + ov[e][1] * ov[e][1]) + (ov[e][2] * ov[e][2] + ov[e][3] * ov[e][3]); }
        ss += __shfl_xor(ss, 1); ss += __shfl_xor(ss, 2); ss += __shfl_xor(ss, 4);
        const float rstd = 1.0f / sqrtf(ss * (1.0f / 192.0f) + 1e-6f);
        const bf16* rrow = P.big + (size_t)(r0 + i) * AINW + 1536 + 192 * h + sg * 24; const float* gn = P.in[20] + sg * 24; bf16* orow = P.mix + (size_t)(r0 + i) * 1024 + 192 * h + sg * 24;
#pragma unroll
        for (int q = 0; q < 3; ++q) { const v4u rw = *(const v4u*)(rrow + q * 8); const f32x4 g0 = *(const f32x4*)(gn + q * 8), g1 = *(const f32x4*)(gn + q * 8 + 4); const f32x4 a = ov[2 * q], bq = ov[2 * q + 1];
            f32x4 y0, y1;
            y0[0] = a[0] * rstd * g0[0] * silu_f(bflo(rw.x)); y0[1] = a[1] * rstd * g0[1] * silu_f(bfhi(rw.x)); y0[2] = a[2] * rstd * g0[2] * silu_f(bflo(rw.y)); y0[3] = a[3] * rstd * g0[3] * silu_f(bfhi(rw.y));
            y1[0] = bq[0] * rstd * g1[0] * silu_f(bflo(rw.z)); y1[1] = bq[1] * rstd * g1[1] * silu_f(bfhi(rw.z)); y1[2] = bq[2] * rstd * g1[2] * silu_f(bflo(rw.w)); y1[3] = bq[3] * rstd * g1[3] * silu_f(bfhi(rw.w));
            *(v4u*)(orow + q * 8) = pk8(y0, y1); } }
    __syncthreads();
}
DI void unit_gla_rec(const Ptrs& P, LAS unsigned char* lds, int u, int tid) {
    const int b = u >> 2, h = u & 3, lane = tid & 63;
    LAS float* EG = (LAS float*)lds; LAS float* QS = EG + 384; LAS float* KS = QS + 384; LAS float* VS = KS + 384; LAS float* RS = VS + 768; LAS float* OP = RS + 768;
    LAS float* G16 = (LAS float*)(lds + GL_G16); LAS float* WG = (LAS float*)(lds + GL_WG); LAS float* BG = (LAS float*)(lds + GL_BG);
    const bf16* rows = P.big + (size_t)(MP + 4 * b) * AINW;
    if (tid < 64) G16[tid] = bf2f(rows[(size_t)(tid >> 4) * AINW + 2560 + (tid & 15)]);
    if (tid < 384) { const int idx = tid * 4, j = idx / 96, d = idx % 96; *(LAS f32x4*)(WG + j * 96 + d) = *(const f32x4*)(P.in[18] + j * 384 + 96 * h + d);
        const int t = tid / 96, dd = tid % 96; QS[tid] = bf2f(rows[(size_t)t * AINW + 96 * h + dd]); KS[tid] = bf2f(rows[(size_t)t * AINW + 384 + 96 * h + dd]); }
    if (tid < 96) BG[tid] = P.in[19][96 * h + tid];
#pragma unroll
    for (int k = 0; k < 2; ++k) { const int idx = tid + 512 * k; if (idx < 768) { const int t = idx / 192, vv = idx % 192; VS[idx] = bf2f(rows[(size_t)t * AINW + 768 + 192 * h + vv]); RS[idx] = bf2f(rows[(size_t)t * AINW + 1536 + 192 * h + vv]); } }
    __syncthreads();
    if (tid < 384) { const int t = tid / 96, d = tid % 96; float z = BG[d];
#pragma unroll
        for (int j = 0; j < 16; ++j) z += G16[t * 16 + j] * WG[j * 96 + d];
        EG[tid] = expf(log_sig16(z)); }
    __syncthreads();
    if (tid < 384) { const int vv = tid % 192, kh = tid / 192; float S[48];
        const float* sin_ = P.in[2] + ((size_t)(b * 4 + h) * 96 + 48 * kh) * 192 + vv; float* sout = P.o_glas + ((size_t)(b * 4 + h) * 96 + 48 * kh) * 192 + vv;
#pragma unroll
        for (int kk = 0; kk < 48; ++kk) S[kk] = sin_[kk * 192];
#pragma unroll
        for (int t = 0; t < 4; ++t) { float a = 0.f; const float vt = VS[t * 192 + vv];
#pragma unroll
            for (int kk = 0; kk < 48; ++kk) { const int d = 48 * kh + kk; S[kk] = EG[t * 96 + d] * S[kk] + KS[t * 96 + d] * vt; a += QS[t * 96 + d] * S[kk]; }
            OP[(kh * 4 + t) * 192 + vv] = a; }
#pragma unroll
        for (int kk = 0; kk < 48; ++kk) sout[kk * 192] = S[kk]; }
    __syncthreads();
    if (tid < 256) { const int t = tid >> 6; float ov[3]; float ss = 0.f;
#pragma unroll
        for (int k = 0; k < 3; ++k) { const int vv = lane + 64 * k; ov[k] = OP[t * 192 + vv] + OP[(4 + t) * 192 + vv]; ss += ov[k] * ov[k]; }
        ss = wave_sum(ss); const float rstd = 1.0f / sqrtf(ss * (1.0f / 192.0f) + 1e-6f);
        bf16* orow = P.mix + (size_t)(MP + 4 * b + t) * 1024 + 192 * h;
#pragma unroll
        for (int k = 0; k < 3; ++k) { const int vv = lane + 64 * k; orow[vv] = f2bf(ov[k] * rstd * P.in[20][vv] * silu_f(RS[t * 192 + vv])); } }
    __syncthreads();
}

struct Args { const float* in[28]; float* out; unsigned char* ws; int ph_lo, ph_hi; };
constexpr int N_PHASES = 18;
template <class Epi> DI void run_gemm(LAS unsigned char* lds, const bf16* A, const bf16* Bt, int M, int N, int K, const Epi& E) {
    pg8::Gemm g{A, Bt, M, N, K}; pg8::StaticOrder S; S.init(M, N, (int)gridDim.x, (int)blockIdx.x);
    pg8::gemm_phase<Epi, pg8::StaticOrder, true, true>(lds, g, S, E);
}
__global__ void __launch_bounds__(512, 2) yoco_fwd(Args args) {
    extern __shared__ __attribute__((aligned(16))) unsigned char lds_raw[];
    LAS unsigned char* lds = (LAS unsigned char*)lds_raw;
    const int tid = threadIdx.x, lane = tid & 63, wave = __builtin_amdgcn_readfirstlane(tid >> 6);
    const int G = gridDim.x, bid = blockIdx.x;
    Ptrs P;
#pragma unroll
    for (int i = 0; i < 28; ++i) P.in[i] = args.in[i];
    P.out = args.out; P.ws = args.ws;
    P.o_y = args.out; P.o_glap = args.out + 17301504; P.o_glas = P.o_glap + 589824; P.o_kp = P.o_glas + 9437184; P.o_vp = P.o_kp + 196608; P.o_ks = P.o_vp + 196608; P.o_vs = P.o_ks + 3145728;
    P.o_mk = P.o_vs + 3145728; P.o_mv = P.o_mk + 1048576;
    P.rope = (float*)(args.ws + WS_ROPE); P.ssq = (float*)(args.ws + WS_SSQ); P.ssqm = (float*)(args.ws + WS_SSQM); P.gdv = (float*)(args.ws + WS_GDV); P.ut = (float*)(args.ws + WS_UT);
    P.xb = (bf16*)(args.ws + WS_XB); P.mpb = (bf16*)(args.ws + WS_MPB); P.mkv = (bf16*)(args.ws + WS_MKV); P.big = (bf16*)(args.ws + WS_BIG); P.mix = (bf16*)(args.ws + WS_MIX); P.kvb = (bf16*)(args.ws + WS_KVB);
    bf16* const wgu = (bf16*)(args.ws + WS_WGU); bf16* const wd = (bf16*)(args.ws + WS_WD);
    bf16* const wain = (bf16*)(args.ws + WS_WAIN); bf16* const waout = (bf16*)(args.ws + WS_WAOUT); bf16* const wbin = (bf16*)(args.ws + WS_WBIN); bf16* const wbout = (bf16*)(args.ws + WS_WBOUT);
    bf16* const wkv = (bf16*)(args.ws + WS_WKV); bf16* const wmkv = (bf16*)(args.ws + WS_WMKV);
    constexpr size_t WGU_STRIDE = 12 * MiB / 2, WD_STRIDE = 5632 * 1024 / 2;

    volatile LAS unsigned* MISC = (volatile LAS unsigned*)(lds + MISC_OFF);
    for (int u = tid; u < 128; u += 512) MISC[u] = 0u;
    __syncthreads();
    const int lo = args.ph_lo, hi = args.ph_hi;
    const bool multi = (hi - lo) > 1;
    XcdBarrier bar; bar.bar = (unsigned*)(args.ws + WS_CTL); bar.x = 0; bar.st = nullptr;
    if (multi) bar = xcd_barrier_post((unsigned*)(args.ws + WS_CTL), MISC + 8);
#ifndef PH_MASK
#define PH_MASK 0x3ffff
#endif
#define IN(k) (((PH_MASK >> (k)) & 1) && lo <= (k) && (k) < hi)
#define SEAM(k) do { if (IN(k) && IN((k) + 1)) xcd_barrier(bar); } while (0)
    float* const xres = P.o_y;

    if (IN(0)) {
        LAS float* scr = (LAS float*)(lds + wave * 16384);
        const int gw = bid * 8 + wave, NGW = G * 8;
        constexpr int I_GU = 16 * 176, I_WD = 44 * 32, I_AIN = 16 * 88, I_SQ = 16 * 32, I_KV = 16 * 16, I_MK = 16 * 16;
        constexpr int NITEMS = 4 * I_GU + 4 * I_WD + I_AIN + 3 * I_SQ + I_KV + 2 * I_MK;
        for (int it = gw; it < NITEMS; it += NGW) {
            int r = it; TJob J;
            if (r < 4 * I_GU) { const int f = r / I_GU; r -= f * I_GU; const int l = f >> 1, second = f & 1;
                J.W = (second ? P.in[13] : P.in[9]) + (size_t)l * 1024 * 5632; J.gain = (second ? P.in[12] : P.in[8]) + l * 1024; J.WT = wgu + f * WGU_STRIDE; J.K = 1024; J.N = 5632; J.nd = 5632; J.kind = TK_GU; }
            else if ((r -= 4 * I_GU) < 4 * I_WD) { const int f = r / I_WD; r -= f * I_WD; const int l = f >> 1, second = f & 1;
                J.W = (second ? P.in[14] : P.in[10]) + (size_t)l * 2816 * 1024; J.gain = nullptr; J.WT = wd + f * WD_STRIDE; J.K = 2816; J.N = 1024; J.nd = 1024; J.kind = TK_ID; }
            else if ((r -= 4 * I_WD) < I_AIN) { J.W = P.in[17]; J.gain = P.in[11]; J.WT = wain; J.K = 1024; J.N = 2576; J.nd = 2816; J.kind = TK_AIN; }
            else if ((r -= I_AIN) < I_SQ) { J.W = P.in[21]; J.gain = nullptr; J.WT = waout; J.K = 1024; J.N = 1024; J.nd = 1024; J.kind = TK_ID; }
            else if ((r -= I_SQ) < I_SQ) { J.W = P.in[24]; J.gain = P.in[11] + 1024; J.WT = wbin; J.K = 1024; J.N = 1024; J.nd = 1024; J.kind = TK_BIN; }
            else if ((r -= I_SQ) < I_SQ) { J.W = P.in[26]; J.gain = nullptr; J.WT = wbout; J.K = 1024; J.N = 1024; J.nd = 1024; J.kind = TK_ID; }
            else if ((r -= I_SQ) < I_KV) { J.W = P.in[23]; J.gain = P.in[22]; J.WT = wkv; J.K = 1024; J.N = 384; J.nd = 512; J.kind = TK_KV; }
            else { r -= I_KV; const int l = r / I_MK; r -= l * I_MK; J.W = P.in[16] + (size_t)l * 1024 * 512; J.gain = P.in[15] + l * 1024; J.WT = wmkv + (size_t)l * 512 * 1024; J.K = 1024; J.N = 512; J.nd = 512; J.kind = TK_ID; }
            p0_transpose_item(J, scr, r, lane);
        }
        for (int m = gw; m < MT + 2048; m += NGW) {
            if (m < MP) row_to_bf16(P.in[0] + (size_t)m * DM, P.xb + (size_t)m * DM, P.ssq + (size_t)m * 16, lane);
            else if (m < MT) row_to_bf16(P.in[1] + (size_t)(m - MP) * DM, P.xb + (size_t)m * DM, P.ssq + (size_t)m * 16, lane);
            else row_to_bf16(P.in[7] + (size_t)(m - MT) * DM, P.mpb + (size_t)(m - MT) * DM, P.ssqm + (size_t)(m - MT) * 16, lane);
        }
        const int gt = bid * 512 + tid, NT = G * 512;
        for (int idx = gt; idx < 2052 * 8; idx += NT) rope_entry(P.rope, idx);
        for (int idx = gt; idx < 2 * 128 * 5952; idx += NT) { const int which = idx / (128 * 5952), rem = idx % (128 * 5952), b = rem / 5952, e = rem % 5952;
            const float* src = (which ? P.in[4] : P.in[3]) + (size_t)b * 24576 + 768 + 4 * e; float* dst = (which ? P.o_vs : P.o_ks) + (size_t)b * 24576 + 4 * e;
            *(f32x4*)dst = *(const f32x4*)src; }
    }
    SEAM(0);
    if (IN(1)) {
        run_gemm(lds, P.mpb, wmkv, 2048, 1024, 1024, pg8::EpiMemKV{P.ssqm, P.mkv, P.o_mk, P.o_mv});
        run_gemm(lds, P.xb, wgu, MT, NGU, 1024, pg8::EpiGU{P.ssq, P.big});
    }
    SEAM(1);
    if (IN(2)) run_gemm(lds, P.big, wd, MT, 1024, FF, pg8::EpiDown{nullptr, P.in[0], P.in[1], xres, P.xb, P.ssq, 0.5f});
    SEAM(2);
    if (IN(3)) run_gemm(lds, P.xb, wain, MT, AINW, 1024, pg8::EpiRowScale{P.ssq, P.big, AINW});
    SEAM(3);
    if (IN(4)) {
        for (int u = bid; u < 1024; u += G) unit_gla_pass1(P, lds, u, tid);
        for (int u = bid; u < 512; u += G) unit_gla_rec(P, lds, u, tid);
        for (int u = bid; u < 512; u += G) unit_mem_sample(P, lds, 0, u, tid);
        for (int u = bid; u < 256; u += G) unit_mem_prompt(P, lds, 0, u, tid);
    }
    SEAM(4);
    if (IN(5)) {
        const int gt = bid * 512 + tid, NT = G * 512;
        for (int idx = gt; idx < 32 * 4608; idx += NT) { const int bh = idx / 4608, e4 = idx % 4608, vv = e4 / 24, d4 = (e4 % 24) * 4;
            float* p = P.ut + (size_t)bh * 32 * 18432 + (size_t)e4 * 4; const float* dv = P.gdv + (size_t)bh * 32 * 96 + d4;
            f32x4 S = {0.f, 0.f, 0.f, 0.f};
#pragma unroll 8
            for (int c = 0; c < 32; ++c) { const f32x4 uv = *(const f32x4*)(p + (size_t)c * 18432); const f32x4 dd = *(const f32x4*)(dv + c * 96); *(f32x4*)(p + (size_t)c * 18432) = S; S = dd * S + uv; }
            float* o = P.o_glap + ((size_t)bh * 96 + d4) * 192 + vv; o[0] = S[0]; o[192] = S[1]; o[384] = S[2]; o[576] = S[3]; }
    }
    SEAM(5);
    if (IN(6)) { for (int u = bid; u < 1024; u += G) unit_gla_pass3(P, lds, u, tid); }
    SEAM(6);
    if (IN(7)) run_gemm(lds, P.mix, waout, MT, 1024, 1024, pg8::EpiDown{nullptr, xres, xres + (size_t)MP * 1024, xres, P.xb, P.ssq, 1.0f});
    SEAM(7);
    if (IN(8)) run_gemm(lds, P.xb, wgu + WGU_STRIDE, MT, NGU, 1024, pg8::EpiGU{P.ssq, P.big});
    SEAM(8);
    if (IN(9)) run_gemm(lds, P.big, wd + WD_STRIDE, MT, 1024, FF, pg8::EpiDown{nullptr, xres, xres + (size_t)MP * 1024, xres, P.xb, P.ssq, 0.5f});
    SEAM(9);
    if (IN(10)) {
        run_gemm(lds, P.xb, wkv, MT, 512, 1024, pg8::EpiKV{P.ssq, P.kvb, P.rope, P.o_kp, P.o_vp, P.o_ks, P.o_vs});
        run_gemm(lds, P.xb, wgu + 2 * WGU_STRIDE, MT, NGU, 1024, pg8::EpiGU{P.ssq, P.big});
    }
    SEAM(10);
    if (IN(11)) run_gemm(lds, P.big, wd + 2 * WD_STRIDE, MT, 1024, FF, pg8::EpiDown{nullptr, xres, xres + (size_t)MP * 1024, xres, P.xb, P.ssq, 0.5f});
    SEAM(11);
    if (IN(12)) run_gemm(lds, P.xb, wbin, MT, 1024, 1024, pg8::EpiInB{P.ssq, P.big, P.rope});
    SEAM(12);
    if (IN(13)) {
#ifndef UM2
#define UM2 15
#endif
        if (UM2 & 1) for (int u = bid; u < 768; u += G) unit_swa_prompt(P, lds, u, tid);
        if (UM2 & 2) for (int u = bid; u < 384; u += G) unit_swa_sample(P, lds, u, tid);
        if (UM2 & 4) for (int u = bid; u < 512; u += G) unit_mem_sample(P, lds, 1, u, tid);
        if (UM2 & 8) for (int u = bid; u < 256; u += G) unit_mem_prompt(P, lds, 1, u, tid);
    }
    SEAM(13);
    if (IN(14)) run_gemm(lds, P.mix, wbout, MT, 1024, 1024, pg8::EpiDown{nullptr, xres, xres + (size_t)MP * 1024, xres, P.xb, P.ssq, 1.0f});
    SEAM(14);
    if (IN(15)) run_gemm(lds, P.xb, wgu + 3 * WGU_STRIDE, MT, NGU, 1024, pg8::EpiGU{P.ssq, P.big});
    SEAM(15);
    if (IN(16)) run_gemm(lds, P.big, wd + 3 * WD_STRIDE, MT, 1024, FF, pg8::EpiDown{nullptr, xres, xres + (size_t)MP * 1024, xres, nullptr, P.ssq, 0.5f});
    SEAM(16);
    if (IN(17)) {
        const int gw = bid * 8 + wave, NGW = G * 8;
        for (int m = gw; m < MT; m += NGW) { f32x4* xr = (f32x4*)(xres + (size_t)m * DM) + lane; const f32x4* gr = (const f32x4*)P.in[27] + lane;
            float s = lane < 16 ? P.ssq[(size_t)m * 16 + lane] : 0.f; s = wave_sum(s); const float rstd = 1.0f / sqrtf(s * (1.0f / 1024.0f) + 1e-6f);
#pragma unroll
            for (int j = 0; j < 4; ++j) { const f32x4 v = xr[64 * j], g = gr[64 * j]; xr[64 * j] = v * rstd * g; } }
    }
#undef IN
#undef SEAM
}

extern "C" void kernel_launch(void* const* d_in, const int* in_sizes, int n_in, void* d_out, int out_size, void* d_ws, size_t ws_size, hipStream_t stream) {
    static int grid = 0;
    if (grid == 0) {
        if (n_in != 28 || ws_size < WS_END) { fprintf(stderr, "kernel_launch: expected 28 inputs and >= %zu bytes of workspace; got %d, %zu\n", (size_t)WS_END, n_in, ws_size); grid = -1; return; }
        int dev = 0, cus = 0, per_cu = 0;
        if (hipGetDevice(&dev) != hipSuccess || hipDeviceGetAttribute(&cus, hipDeviceAttributeMultiprocessorCount, dev) != hipSuccess) { grid = -1; return; }
        if (hipFuncSetAttribute((const void*)yoco_fwd, hipFuncAttributeMaxDynamicSharedMemorySize, LDS_BYTES) != hipSuccess) { fprintf(stderr, "kernel_launch: hipFuncSetAttribute failed\n"); grid = -1; return; }
        if (hipOccupancyMaxActiveBlocksPerMultiprocessor(&per_cu, (const void*)yoco_fwd, 512, LDS_BYTES) != hipSuccess || per_cu < 1) fprintf(stderr, "kernel_launch: occupancy query reports %d blocks per CU\n", per_cu);
        (void)hipGetLastError();
        grid = cus;
    }
    if (grid < 0) return;
    Args a{};
    for (int i = 0; i < 28; ++i) a.in[i] = (const float*)d_in[i];
    a.out = (float*)d_out; a.ws = (unsigned char*)d_ws;
#if MK_ONE_LAUNCH
    (void)hipMemsetAsync((char*)d_ws + WS_CTL, 0, CTL_ZERO_BYTES, stream);
    a.ph_lo = 0; a.ph_hi = N_PHASES;
    hipLaunchKernelGGL(yoco_fwd, dim3(grid), dim3(512), LDS_BYTES, stream, a);
#else
    for (int p = 0; p < N_PHASES; ++p) { a.ph_lo = p; a.ph_hi = p + 1; hipLaunchKernelGGL(yoco_fwd, dim3(grid), dim3(512), LDS_BYTES, stream, a); }
#endif
}
```

```cpp
#include <hip/hip_runtime.h>
#include <cstdio>
#include <cstdint>

#ifndef REP_P4
#define REP_P4 1
#endif
#ifndef REP_P6
#define REP_P6 1
#endif
#ifndef REP_P13
#define REP_P13 1
#endif
#ifndef REP_P0
#define REP_P0 1
#endif
#ifndef MK_ONE_LAUNCH
#define MK_ONE_LAUNCH 1
#endif

namespace pg8 {
#define PG8_LAS __attribute__((address_space(3)))
typedef unsigned short bf16_t;
typedef short bf16x8 __attribute__((ext_vector_type(8)));
typedef float f32x4 __attribute__((ext_vector_type(4)));
typedef unsigned u32x4 __attribute__((ext_vector_type(4)));
constexpr int BM = 256, BK = 64, HALF = 128, HTB = HALF * BK * 2  , STAGE_BYTES = 8 * HTB, NXCD = 8, WGM = 8;

__host__ __device__ __forceinline__ int lds_byte(int r, int c) { const int st = (r >> 4) * 2 + (c >> 5), rr = r & 15, cc = c & 31, ob = rr * 64 + cc * 2; return st * 1024 + (ob ^ (((ob >> 9) & 1) << 5)); }
__host__ __device__ __forceinline__ void stage_rc(int b, int& R, int& C) { const int st = b / 1024, sb = b % 1024, swz = sb ^ (((sb >> 9) & 1) << 5); R = (st >> 1) * 16 + swz / 64; C = (st & 1) * 32 + (swz % 64) / 2; }
__host__ __device__ __forceinline__ int perm32(int rho) { const int n = rho >> 4, i = rho & 15; return 8 * (i >> 2) + 4 * n + (i & 3); }

struct Unit { int pm, pn; };
struct Gemm { const bf16_t* A; const bf16_t* Bt; int M, N, K; };

struct StaticOrder {
    int nM, nN, nwg, G, c;
    __host__ __device__ void init(int M, int N, int G_, int c_) { nM = M / BM; nN = N / BM; nwg = nM * nN; G = G_; c = c_; }
    __host__ __device__ bool next(int i, Unit& u) const {
        const long L = (long)i * G + c; if (L >= nwg) return false;
        int wgid = (int)L; { const int q = nwg / NXCD, r = nwg % NXCD, xcd = wgid % NXCD, off = wgid / NXCD; wgid = (xcd < r ? xcd * (q + 1) : r * (q + 1) + (xcd - r) * q) + off; }
        const int nig = WGM * nN, gid = wgid / nig, fm = gid * WGM, gsz = (nM - fm) < WGM ? (nM - fm) : WGM;
        u.pm = fm + ((wgid % nig) % gsz); u.pn = (wgid % nig) / gsz; return true;
    }
    __device__ __forceinline__ void a_ready(const Unit&) const {}
    __device__ __forceinline__ void done(const Unit&) const {}
};


constexpr int MPROWS = 16384, FFD = 2816;
typedef float f32x2_t __attribute__((ext_vector_type(2))); typedef __bf16 bf16x2_t __attribute__((ext_vector_type(2)));
__device__ __forceinline__ unsigned pk2(float lo, float hi) { f32x2_t v = {lo, hi}; bf16x2_t b = __builtin_convertvector(v, bf16x2_t); return __builtin_bit_cast(unsigned, b); }
__device__ __forceinline__ u32x4 pk8(f32x4 a, f32x4 b) { u32x4 w; w.x = pk2(a[0], a[1]); w.y = pk2(a[2], a[3]); w.z = pk2(b[0], b[1]); w.w = pk2(b[2], b[3]); return w; }
__device__ __forceinline__ float silu_f(float g) { return g * __builtin_amdgcn_rcpf(1.0f + __builtin_amdgcn_exp2f(-1.4426950408889634f * g)); }

struct EpiGU { static constexpr bool PERM = true, RSTD = true; const float* ssq; bf16_t* H;
    __device__ __forceinline__ void operator()(const f32x4 (&acc)[2][2][4][2], const Unit& u, int wr, int wc, int fr, int fq, const PG8_LAS float* tab) const {
        const int col0 = u.pn * 128 + wc * 32 + 8 * fq;
#pragma unroll
        for (int ai = 0; ai < 2; ++ai)
#pragma unroll
            for (int m = 0; m < 4; ++m) { const int lr = ai * HALF + wr * 64 + m * 16 + fr; const float rs = tab[lr];
                bf16_t* rowp = H + (size_t)(u.pm * BM + lr) * FFD + col0;
                f32x4 h0, h1;
#pragma unroll
                for (int e = 0; e < 4; ++e) { h0[e] = silu_f(acc[ai][0][m][0][e] * rs) * (acc[ai][1][m][0][e] * rs); h1[e] = silu_f(acc[ai][0][m][1][e] * rs) * (acc[ai][1][m][1][e] * rs); }
                *(u32x4*)rowp = pk8(h0, h1); }
    }
};
struct EpiDown { static constexpr bool PERM = false, RSTD = false; const float* ssq_unused; const float* baseP; const float* baseS; float* out; bf16_t* xb; float* ssq; float scale;
    __device__ __forceinline__ void operator()(const f32x4 (&acc)[2][2][4][2], const Unit& u, int wr, int wc, int fr, int fq, const PG8_LAS float* tab) const {
        const int col0 = u.pn * BM + wc * 32 + 4 * fq;
        typedef unsigned u32x2v __attribute__((ext_vector_type(2)));
#pragma unroll
        for (int ai = 0; ai < 2; ++ai)
#pragma unroll
            for (int m = 0; m < 4; ++m) { const int grow = u.pm * BM + ai * HALF + wr * 64 + m * 16 + fr;
                const float* bp = (grow < MPROWS) ? baseP + (size_t)grow * 1024 : baseS + (size_t)(grow - MPROWS) * 1024;
                float ss = 0.f;
#pragma unroll
                for (int bj = 0; bj < 2; ++bj)
#pragma unroll
                    for (int n = 0; n < 2; ++n) { const int c = col0 + bj * HALF + n * 16; const f32x4 b = *(const f32x4*)(bp + c); const f32x4 v = b + acc[ai][bj][m][n] * scale;
                        *(f32x4*)(out + (size_t)grow * 1024 + c) = v;
                        if (xb) { u32x2v w; w.x = pk2(v[0], v[1]); w.y = pk2(v[2], v[3]); *(u32x2v*)(xb + (size_t)grow * 1024 + c) = w; }
                        ss += (v[0] * v[0] + v[1] * v[1]) + (v[2] * v[2] + v[3] * v[3]); }
                ss += __shfl_xor(ss, 16); ss += __shfl_xor(ss, 32);
                if (fq == 0) ssq[(size_t)grow * 16 + u.pn * 4 + wc] = ss;
                if (m & 1) asm volatile("" ::: "memory"); }
    }
};
struct EpiRowScale { static constexpr bool PERM = true, RSTD = true; const float* ssq; bf16_t* O; int ldc;
    __device__ __forceinline__ void operator()(const f32x4 (&acc)[2][2][4][2], const Unit& u, int wr, int wc, int fr, int fq, const PG8_LAS float* tab) const {
        const int col0 = u.pn * BM + wc * 32 + 8 * fq;
#pragma unroll
        for (int ai = 0; ai < 2; ++ai)
#pragma unroll
            for (int m = 0; m < 4; ++m) { const int lr = ai * HALF + wr * 64 + m * 16 + fr; const float rs = tab[lr];
                bf16_t* rowp = O + (size_t)(u.pm * BM + lr) * ldc + col0;
#pragma unroll
                for (int bj = 0; bj < 2; ++bj) *(u32x4*)(rowp + bj * HALF) = pk8(acc[ai][bj][m][0] * rs, acc[ai][bj][m][1] * rs); }
    }
};
__device__ __forceinline__ void rope8(f32x4& v0, f32x4& v1, int fq, const float* rp) {
    f32x4 o0, o1;
#pragma unroll
    for (int e = 0; e < 4; ++e) { o0[e] = __shfl_xor(v0[e], 16); o1[e] = __shfl_xor(v1[e], 16); }
    if (fq < 2) { const f32x4 c0 = *(const f32x4*)rp, c1 = *(const f32x4*)(rp + 4), s0 = *(const f32x4*)(rp + 8), s1 = *(const f32x4*)(rp + 12);
        const float sg = fq == 0 ? -1.f : 1.f; v0 = v0 * c0 + (o0 * s0) * sg; v1 = v1 * c1 + (o1 * s1) * sg; }
}
__device__ __forceinline__ int pos_index(int grow) { return grow < MPROWS ? (grow & 2047) : 2048 + ((grow - MPROWS) & 3); }
struct EpiInB { static constexpr bool PERM = true, RSTD = true; const float* ssq; bf16_t* O; const float* rope;
    __device__ __forceinline__ void operator()(const f32x4 (&acc)[2][2][4][2], const Unit& u, int wr, int wc, int fr, int fq, const PG8_LAS float* tab) const {
        const int col0 = u.pn * BM + wc * 32 + 8 * fq; const bool rot = (u.pn < 3) && ((wc & 1) == 0);
#pragma unroll
        for (int ai = 0; ai < 2; ++ai)
#pragma unroll
            for (int m = 0; m < 4; ++m) { const int lr = ai * HALF + wr * 64 + m * 16 + fr, grow = u.pm * BM + lr; const float rs = tab[lr];
                bf16_t* rowp = O + (size_t)grow * 1024 + col0; const float* rp = rope + pos_index(grow) * 16;
#pragma unroll
                for (int bj = 0; bj < 2; ++bj) { f32x4 v0 = acc[ai][bj][m][0] * rs, v1 = acc[ai][bj][m][1] * rs; if (rot) rope8(v0, v1, fq, rp); *(u32x4*)(rowp + bj * HALF) = pk8(v0, v1); } }
    }
};
struct EpiKV { static constexpr bool PERM = true, RSTD = true; const float* ssq; bf16_t* KVB; const float* rope; float* okp; float* ovp; float* oks; float* ovs;
    __device__ __forceinline__ void operator()(const f32x4 (&acc)[2][2][4][2], const Unit& u, int wr, int wc, int fr, int fq, const PG8_LAS float* tab) const {
#pragma unroll
        for (int bj = 0; bj < 2; ++bj) { const int wcol = u.pn * BM + bj * HALF + wc * 32; if (wcol >= 384) continue;
            const bool isk = wcol < 192, rot = isk && ((wc & 1) == 0); const int c0 = wcol + 8 * fq, cc = isk ? c0 : c0 - 192;
#pragma unroll
            for (int ai = 0; ai < 2; ++ai)
#pragma unroll
                for (int m = 0; m < 4; ++m) { const int lr = ai * HALF + wr * 64 + m * 16 + fr, grow = u.pm * BM + lr; const float rs = tab[lr];
                    f32x4 v0 = acc[ai][bj][m][0] * rs, v1 = acc[ai][bj][m][1] * rs; if (rot) rope8(v0, v1, fq, rope + pos_index(grow) * 16);
                    *(u32x4*)(KVB + (size_t)grow * 384 + c0) = pk8(v0, v1);
                    float* dst = nullptr;
                    if (grow < MPROWS) { const int t = grow & 2047; if (t >= 1920) dst = (isk ? okp : ovp) + (size_t)((grow >> 11) * 128 + t - 1920) * 192 + cc; }
                    else { const int r2 = grow - MPROWS; dst = (isk ? oks : ovs) + (size_t)((r2 >> 2) * 128 + 124 + (r2 & 3)) * 192 + cc; }
                    if (dst) { *(f32x4*)dst = v0; *(f32x4*)(dst + 4) = v1; } } }
    }
};
struct EpiMemKV { static constexpr bool PERM = true, RSTD = true; const float* ssq; bf16_t* MKV; float* okm; float* ovm;
    __device__ __forceinline__ void operator()(const f32x4 (&acc)[2][2][4][2], const Unit& u, int wr, int wc, int fr, int fq, const PG8_LAS float* tab) const {
        const int l = u.pn >> 1; float* ob = (u.pn & 1) ? ovm : okm;
#pragma unroll
        for (int ai = 0; ai < 2; ++ai)
#pragma unroll
            for (int m = 0; m < 4; ++m) { const int lr = ai * HALF + wr * 64 + m * 16 + fr, grow = u.pm * BM + lr; const float rs = tab[lr];
#pragma unroll
                for (int bj = 0; bj < 2; ++bj) { const int hd = bj * HALF + wc * 32 + 8 * fq; const f32x4 v0 = acc[ai][bj][m][0] * rs, v1 = acc[ai][bj][m][1] * rs;
                    float* dst = ob + (size_t)(l * 2048 + grow) * 256 + hd; *(f32x4*)dst = v0; *(f32x4*)(dst + 4) = v1;
                    *(u32x4*)(MKV + (size_t)grow * 1024 + u.pn * BM + hd) = pk8(v0, v1); } }
    }
};
__device__ __forceinline__ void prep_rstd(const float* ssq, const Unit& u, PG8_LAS float* tab, int tid) {
    const float* p = ssq + ((size_t)(u.pm * BM + (tid >> 1)) * 16 + (tid & 1) * 8);
    const f32x4 a = *(const f32x4*)p, b = *(const f32x4*)(p + 4);
    float s = ((a[0] + a[1]) + (a[2] + a[3])) + ((b[0] + b[1]) + (b[2] + b[3]));
    s += __shfl_xor(s, 1);
    if (!(tid & 1)) tab[tid >> 1] = 1.0f / sqrtf(s * (1.0f / 1024.0f) + 1e-6f);
}
template <class Epi, class Sched, bool ALIGN_EPI = false, bool SP2 = false>
__device__ __forceinline__ void gemm_phase(PG8_LAS unsigned char* lds, const Gemm g, const Sched& S, const Epi& E) {
    const int tid = threadIdx.x, wid = __builtin_amdgcn_readfirstlane(tid >> 6), lane = tid & 63, wr = wid >> 2, wc = wid & 3, fr = lane & 15, fq = lane >> 4;
    const int K = g.K, nt = K / BK;
    unsigned voffA[2], voffB[2];
#pragma unroll
    for (int i = 0; i < 2; ++i) { int R, C; stage_rc(tid * 16 + i * 8192, R, C); const int Rb = Epi::PERM ? ((R & ~31) + perm32(R & 31)) : R;
        voffA[i] = (unsigned)(R * K + C) * 2u; voffB[i] = (unsigned)(Rb * K + C) * 2u; }
    const size_t kstep = (size_t)(BK * 2);
    const size_t hstep = (size_t)HALF * K * 2;
    const size_t tstep = 2 * hstep;
    const unsigned ldsw = (unsigned)wid * 1024u;
    const int aoff = lds_byte(wr * 64 + fr, fq * 8), boff = lds_byte(wc * 32 + fr, fq * 8);
#define PG8_SA(b, h) (((b) * 2 + (h)) * HTB)
#define PG8_SB(b, h) ((4 + (b) * 2 + (h)) * HTB)
#define PG8_STAGE(bufoff, gbase, voff) do { _Pragma("unroll") for (int _i = 0; _i < 2; ++_i) \
        __builtin_amdgcn_global_load_lds((const unsigned*)((const char*)(gbase) + (voff)[_i]), (PG8_LAS unsigned*)(lds + (bufoff) + ldsw + _i * 8192), 16, 0, 0); } while (0)
#define PG8_LDA(dst, b, h) do { _Pragma("unroll") for (int m = 0; m < 4; ++m) _Pragma("unroll") for (int k = 0; k < 2; ++k) dst[m][k] = *(const PG8_LAS bf16x8*)(lds + PG8_SA(b, h) + aoff + m * 2048 + k * 1024); } while (0)
#define PG8_LDB(dst, b, h) do { _Pragma("unroll") for (int n = 0; n < 2; ++n) _Pragma("unroll") for (int k = 0; k < 2; ++k) dst[n][k] = *(const PG8_LAS bf16x8*)(lds + PG8_SB(b, h) + boff + n * 2048 + k * 1024); } while (0)
#define PG8_MMA(ai, bj, At, Bt) do { __builtin_amdgcn_s_setprio(1); _Pragma("unroll") for (int m = 0; m < 4; ++m) _Pragma("unroll") for (int n = 0; n < 2; ++n) _Pragma("unroll") for (int k = 0; k < 2; ++k) \
        acc[ai][bj][m][n] = __builtin_amdgcn_mfma_f32_16x16x32_bf16(Bt[n][k], At[m][k], acc[ai][bj][m][n], 0, 0, 0); __builtin_amdgcn_s_setprio(0); } while (0)
#define PG8_WAIT_V(n) asm volatile("s_waitcnt vmcnt(" #n ")" ::: "memory")
#define PG8_WAIT_L(n) asm volatile("s_waitcnt lgkmcnt(" #n ")" ::: "memory")
#define PG8_BAR __builtin_amdgcn_s_barrier()
#define PG8_SCHED __builtin_amdgcn_sched_barrier(0)
    Unit cur, nxt; int ui = 0;
    if (!S.next(0, cur)) return;
    PG8_LAS float* const tabs = (PG8_LAS float*)(lds + STAGE_BYTES);
    if constexpr (Epi::RSTD) prep_rstd(E.ssq, cur, tabs, tid);
    f32x4 acc[2][2][4][2];
#pragma unroll
    for (int a = 0; a < 2; ++a)
#pragma unroll
        for (int b = 0; b < 2; ++b)
#pragma unroll
            for (int m = 0; m < 4; ++m)
#pragma unroll
                for (int n = 0; n < 2; ++n) acc[a][b][m][n] = (f32x4){0.f, 0.f, 0.f, 0.f};
    bf16x8 At[4][2], B0[2][2], B1[2][2];
    const char* cA = (const char*)g.A + (size_t)cur.pm * tstep; const char* cB = (const char*)g.Bt + (size_t)cur.pn * tstep;
    S.a_ready(cur);
    if constexpr (SP2) {
        PG8_STAGE(PG8_SB(0, 0), cB, voffB); PG8_STAGE(PG8_SB(0, 1), cB + hstep, voffB); PG8_STAGE(PG8_SA(0, 0), cA, voffA); PG8_STAGE(PG8_SA(0, 1), cA + hstep, voffA);
        if (wr == 1) PG8_BAR;
        PG8_WAIT_V(2); PG8_BAR;
        PG8_STAGE(PG8_SB(1, 0), cB + kstep, voffB); PG8_STAGE(PG8_SA(1, 0), cA + kstep, voffA); PG8_STAGE(PG8_SB(1, 1), cB + hstep + kstep, voffB);
        PG8_WAIT_V(6); PG8_BAR;
    } else {
        PG8_STAGE(PG8_SB(0, 0), cB, voffB); PG8_STAGE(PG8_SA(0, 0), cA, voffA); PG8_STAGE(PG8_SB(0, 1), cB + hstep, voffB); PG8_STAGE(PG8_SA(0, 1), cA + hstep, voffA);
        if (wr == 1) PG8_BAR;
        PG8_WAIT_V(4); PG8_BAR;
        PG8_STAGE(PG8_SB(1, 0), cB + kstep, voffB); PG8_STAGE(PG8_SA(1, 0), cA + kstep, voffA); PG8_STAGE(PG8_SB(1, 1), cB + hstep + kstep, voffB);
        PG8_WAIT_V(6); PG8_BAR;
    }
    for (;;) {
        const bool has_next = S.next(ui + 1, nxt);
        const char* nA = has_next ? (const char*)g.A + (size_t)nxt.pm * tstep : cA; const char* nB = has_next ? (const char*)g.Bt + (size_t)nxt.pn * tstep : cB;
        for (int t = 0; t < nt; t += 2) {
            const bool last = (t == nt - 2);
            const char* a1 = cA + (size_t)(t + 1) * kstep;
            const char* a2 = last ? nA : cA + (size_t)(t + 2) * kstep; const char* b2 = last ? nB : cB + (size_t)(t + 2) * kstep;
            const char* a3 = a2 + kstep; const char* b3 = b2 + kstep;
            if (last && has_next) S.a_ready(nxt);
            if constexpr (SP2) {
            PG8_LDB(B0, 0, 0); PG8_LDB(B1, 0, 1); PG8_SCHED; PG8_LDA(At, 0, 0); PG8_STAGE(PG8_SA(1, 1), a1 + hstep, voffA);
            PG8_WAIT_V(8); PG8_WAIT_L(0); PG8_BAR; PG8_MMA(0, 0, At, B0); PG8_MMA(0, 1, At, B1); PG8_BAR; PG8_SCHED;
            PG8_LDA(At, 0, 1); PG8_STAGE(PG8_SB(0, 0), b2, voffB); PG8_STAGE(PG8_SB(0, 1), b2 + hstep, voffB); PG8_STAGE(PG8_SA(0, 0), a2, voffA);
            PG8_WAIT_V(8); PG8_WAIT_L(0); PG8_BAR; PG8_MMA(1, 0, At, B0); PG8_MMA(1, 1, At, B1); PG8_BAR; PG8_SCHED;
            PG8_LDB(B0, 1, 0); PG8_LDB(B1, 1, 1); PG8_SCHED; PG8_LDA(At, 1, 0); PG8_STAGE(PG8_SA(0, 1), a2 + hstep, voffA);
            PG8_WAIT_V(8); PG8_WAIT_L(0); PG8_BAR; PG8_MMA(0, 0, At, B0); PG8_MMA(0, 1, At, B1); PG8_BAR; PG8_SCHED;
            PG8_LDA(At, 1, 1); PG8_STAGE(PG8_SB(1, 0), b3, voffB); PG8_STAGE(PG8_SB(1, 1), b3 + hstep, voffB); PG8_STAGE(PG8_SA(1, 0), a3, voffA);
            PG8_WAIT_V(8); PG8_WAIT_L(0); PG8_BAR; PG8_MMA(1, 0, At, B0); PG8_MMA(1, 1, At, B1); PG8_BAR; PG8_SCHED;
            } else {
            PG8_LDB(B0, 0, 0); PG8_SCHED; PG8_LDA(At, 0, 0); PG8_STAGE(PG8_SA(1, 1), a1 + hstep, voffA);
            PG8_WAIT_L(8); PG8_BAR; PG8_WAIT_L(0); PG8_MMA(0, 0, At, B0); PG8_BAR; PG8_SCHED;
            PG8_LDB(B1, 0, 1); PG8_STAGE(PG8_SB(0, 0), b2, voffB);
            PG8_BAR; PG8_WAIT_L(0); PG8_MMA(0, 1, At, B1); PG8_BAR;
            PG8_LDA(At, 0, 1); PG8_STAGE(PG8_SA(0, 0), a2, voffA);
            PG8_BAR; PG8_WAIT_L(0); PG8_MMA(1, 0, At, B0); PG8_BAR; PG8_SCHED;
            PG8_STAGE(PG8_SB(0, 1), b2 + hstep, voffB);
            PG8_WAIT_V(6); PG8_BAR; PG8_MMA(1, 1, At, B1); PG8_BAR;
            PG8_LDB(B0, 1, 0); PG8_SCHED; PG8_LDA(At, 1, 0); PG8_STAGE(PG8_SA(0, 1), a2 + hstep, voffA);
            PG8_WAIT_L(8); PG8_BAR; PG8_WAIT_L(0); PG8_MMA(0, 0, At, B0); PG8_BAR; PG8_SCHED;
            PG8_LDB(B1, 1, 1); PG8_STAGE(PG8_SB(1, 0), b3, voffB);
            PG8_BAR; PG8_WAIT_L(0); PG8_MMA(0, 1, At, B1); PG8_BAR;
            PG8_LDA(At, 1, 1); PG8_STAGE(PG8_SA(1, 0), a3, voffA);
            PG8_BAR; PG8_WAIT_L(0); PG8_MMA(1, 0, At, B0); PG8_BAR; PG8_SCHED;
            PG8_STAGE(PG8_SB(1, 1), b3 + hstep, voffB);
            PG8_WAIT_V(6); PG8_BAR; PG8_MMA(1, 1, At, B1); PG8_BAR;
            }
        }
        if constexpr (ALIGN_EPI) { if (wr == 0) PG8_BAR; }
        E(acc, cur, wr, wc, fr, fq, tabs + (ui & 1) * 256);
        if constexpr (Epi::RSTD) { if (has_next) prep_rstd(E.ssq, nxt, tabs + ((ui + 1) & 1) * 256, tid); }
        if (!has_next) break;
#pragma unroll
        for (int a = 0; a < 2; ++a)
#pragma unroll
            for (int b = 0; b < 2; ++b)
#pragma unroll
                for (int m = 0; m < 4; ++m)
#pragma unroll
                    for (int n = 0; n < 2; ++n) acc[a][b][m][n] = (f32x4){0.f, 0.f, 0.f, 0.f};
        cur = nxt; cA = nA; cB = nB; ++ui;
        if constexpr (ALIGN_EPI) { if (wr == 1) PG8_BAR; }
    }
    PG8_WAIT_V(0);
    if constexpr (!ALIGN_EPI) { if (wr == 0) PG8_BAR; }
    PG8_BAR;
#undef PG8_SA
#undef PG8_SB
#undef PG8_STAGE
#undef PG8_LDA
#undef PG8_LDB
#undef PG8_MMA
#undef PG8_WAIT_V
#undef PG8_WAIT_L
#undef PG8_BAR
#undef PG8_SCHED
}
}

using pg8::bf16x8; using pg8::f32x4; using pg8::u32x4; using pg8::pk2; using pg8::pk8; using pg8::silu_f;
typedef unsigned short bf16;
#define LAS __attribute__((address_space(3)))
#define DI __device__ __forceinline__
typedef unsigned v4u __attribute__((ext_vector_type(4)));
typedef unsigned v2u __attribute__((ext_vector_type(2)));
typedef float f32x16 __attribute__((ext_vector_type(16)));
typedef short s16x4 __attribute__((ext_vector_type(4)));
#define RLX_AGENT __ATOMIC_RELAXED, __HIP_MEMORY_SCOPE_AGENT

constexpr int DM = 1024, MP = 16384, MS = 512, MT = MP + MS, SEQL = 2048, FF = 2816, NGU = 5632, AINW = 2816;
constexpr float C2 = 0.18033688011112042f;
constexpr float LOG2E = 1.4426950408889634f;
constexpr size_t MiB = 1u << 20;
constexpr size_t WS_CTL = 0, CTL_ZERO_BYTES = 64 * 1024;
constexpr size_t WS_ROPE = 1 * MiB;
constexpr size_t WS_SSQ = WS_ROPE + 256 * 1024;
constexpr size_t WS_SSQM = WS_SSQ + 1280 * 1024;
constexpr size_t WS_GDV = WS_SSQM + 256 * 1024;
constexpr size_t WS_WGU = 4 * MiB;
constexpr size_t WS_WD = WS_WGU + 48 * MiB;
constexpr size_t WS_WAIN = WS_WD + 22 * MiB;
constexpr size_t WS_WAOUT = WS_WAIN + 5632 * 1024;
constexpr size_t WS_WBIN = WS_WAOUT + 2 * MiB;
constexpr size_t WS_WBOUT = WS_WBIN + 2 * MiB;
constexpr size_t WS_WKV = WS_WBOUT + 2 * MiB;
constexpr size_t WS_WMKV = WS_WKV + 1 * MiB;
constexpr size_t WS_XB = WS_WMKV + 2 * MiB;
constexpr size_t WS_MPB = WS_XB + 33 * MiB;
constexpr size_t WS_MKV = WS_MPB + 4 * MiB;
constexpr size_t WS_BIG = WS_MKV + 4 * MiB;
constexpr size_t WS_MIX = WS_BIG + 91 * MiB;
constexpr size_t WS_KVB = WS_MIX + 33 * MiB;
constexpr size_t WS_UT = WS_KVB + 13 * MiB;
constexpr size_t WS_END = WS_UT + 72 * MiB;
constexpr int LDS_BYTES = 147456, MISC_OFF = LDS_BYTES - 512;

DI float bflo(unsigned w) { return __uint_as_float(w << 16); }
DI float bfhi(unsigned w) { return __uint_as_float(w & 0xffff0000u); }
DI float bf2f(unsigned short h) { return __uint_as_float((unsigned)h << 16); }
DI unsigned short f2bf(float f) { return (unsigned short)(pk2(f, 0.f) & 0xffffu); }
DI float wave_sum(float v) {
#pragma unroll
    for (int o = 1; o < 64; o <<= 1) v += __shfl_xor(v, o);
    return v;
}
#define XB_TMO      128
#define XB_XCNT(j)  (256  + 64 * (j))
#define XB_XSUB(j)  (1280 + 64 * (j))
#define XB_XGEN(j)  (2304 + 64 * (j))
#define XB_TOP      3328
#define XB_TOPGEN   3392
#define XCD_BAR_WORDS 3456
#define XB_SPIN_CAP (1u << 18)

__device__ __forceinline__ unsigned xb_ld(unsigned* p)              { return __hip_atomic_load(p, __ATOMIC_RELAXED, __HIP_MEMORY_SCOPE_AGENT); }
__device__ __forceinline__ unsigned xb_add(unsigned* p, unsigned v) { return __hip_atomic_fetch_add(p, v, __ATOMIC_RELAXED, __HIP_MEMORY_SCOPE_AGENT); }
__device__ __forceinline__ unsigned xb_xcc_id() { return (unsigned)__builtin_amdgcn_s_getreg((3 << 11) | 20) & 0xFu; }
#define XB_SPIN(cond, bar) do { unsigned _sp = 0; while (cond) { __builtin_amdgcn_s_sleep(1); \
    if ((++_sp & 255u) == 0u) { if (xb_ld(&(bar)[XB_TMO])) break; if (_sp > XB_SPIN_CAP) { atomicAdd(&(bar)[XB_TMO], 1u); break; } } } } while (0)

struct XcdBarrier {
    unsigned* bar; unsigned x;
    volatile LAS unsigned* st;
};

__device__ __forceinline__ XcdBarrier xcd_barrier_post(unsigned* bar, volatile LAS unsigned* st) {
    XcdBarrier b; b.bar = bar; b.x = xb_xcc_id(); b.st = st;
    if (threadIdx.x == 0) (void)xb_add(&bar[XB_XCNT(b.x)], 1u);
    return b;
}
__device__ __forceinline__ void xcd_barrier_complete(unsigned* bar, unsigned x, unsigned& nloc, unsigned& nx) {
    const unsigned G = gridDim.x * gridDim.y * gridDim.z;
    unsigned sum, cnt, mine, sp = 0u;
    for (;;) {
        sum = 0u; cnt = 0u; mine = 0u;
#pragma unroll
        for (unsigned j = 0; j < 16; ++j) { const unsigned c = xb_ld(&bar[XB_XCNT(j)]); sum += c; cnt += (c > 0u) ? 1u : 0u; mine = (j == x) ? c : mine; }
        if (sum == G) break;
        __builtin_amdgcn_s_sleep(1);
        if ((++sp & 255u) == 0u) { if (xb_ld(&bar[XB_TMO])) break; if (sp > XB_SPIN_CAP) { atomicAdd(&bar[XB_TMO], 1u); break; } }
    }
    nloc = mine > 0u ? mine : 1u; nx = cnt > 0u ? cnt : 1u;
}

__device__ __forceinline__ void xcd_barrier(const XcdBarrier& b) {
    asm volatile("s_waitcnt vmcnt(0)" ::: "memory");
    __syncthreads();
    if (threadIdx.x == 0) {
        unsigned* bar = b.bar;
        __builtin_amdgcn_s_waitcnt(0);
        unsigned nloc = b.st[0], nx = b.st[1];
        if (nloc == 0u) { xcd_barrier_complete(bar, b.x, nloc, nx); b.st[0] = nloc; b.st[1] = nx; }
        const unsigned old = xb_add(&bar[XB_XSUB(b.x)], 1u);
        const unsigned gen = old / nloc;
        if (old + 1u == (gen + 1u) * nloc) {
            __builtin_amdgcn_fence(__ATOMIC_RELEASE, "agent");
            asm volatile("s_waitcnt vmcnt(0)" ::: "memory");
            const unsigned og = xb_add(&bar[XB_TOP], 1u);
            const unsigned tg = og / nx;
            if (og + 1u == (tg + 1u) * nx) xb_add(&bar[XB_TOPGEN], 1u);
            else XB_SPIN(xb_ld(&bar[XB_TOPGEN]) == tg, bar);
            __builtin_amdgcn_fence(__ATOMIC_ACQUIRE, "agent");
            xb_add(&bar[XB_XGEN(b.x)], 1u);
            asm volatile("s_waitcnt vmcnt(0)" ::: "memory");
        } else {
            XB_SPIN(xb_ld(&bar[XB_XGEN(b.x)]) == gen, bar);
            __builtin_amdgcn_fence(__ATOMIC_ACQUIRE, "agent");
            asm volatile("s_waitcnt vmcnt(0)" ::: "memory");
        }
    }
    __syncthreads();
}

enum { TK_ID = 0, TK_GU = 1, TK_AIN = 2, TK_BIN = 3, TK_KV = 4 };
struct TJob { const float* W; const float* gain; bf16* WT; int K, N, nd, kind; };
DI void map_row(int kind, int n, int& src, float& sc) {
    src = n; sc = 1.f;
    if (kind == TK_GU) { const int t = n >> 8, w = n & 255; src = (w < 128) ? 128 * t + w : 2816 + 128 * t + (w - 128); }
    else if (kind == TK_AIN) {
        if (n < 384) sc = 0.10206207261596575f;
        else if (n < 2304) {}
        else if (n < 2560) { src = 2320 + (n - 2304); sc = C2; }
        else if (n < 2576) src = 2304 + (n - 2560);
        else src = -1; }
    else if (kind == TK_BIN) sc = C2;
    else if (kind == TK_KV) { if (n >= 384) src = -1; }
}
DI void p0_transpose_item(const TJob& J, LAS float* scr, int item, int lane) {
    const int nblk = J.nd / 32, kb = item / nblk, nb = item % nblk, k0 = 64 * kb, n0 = 32 * nb;
    int src; float sc; map_row(J.kind, n0 + (lane & 31), src, sc);
    float vals[32];
#pragma unroll
    for (int i = 0; i < 32; ++i) { const int kk = 2 * i + (lane >> 5); vals[i] = (src >= 0) ? J.W[(size_t)(k0 + kk) * J.N + src] : 0.f; }
    if (J.gain) {
#pragma unroll
        for (int i = 0; i < 32; ++i) vals[i] *= J.gain[k0 + 2 * i + (lane >> 5)]; }
#pragma unroll
    for (int i = 0; i < 32; ++i) scr[(2 * i + (lane >> 5)) * 33 + (lane & 31)] = vals[i] * sc;
    asm volatile("s_waitcnt lgkmcnt(0)" ::: "memory");
    const int c = lane & 7;
#pragma unroll
    for (int j = 0; j < 4; ++j) { const int n = (lane >> 3) + 8 * j; const LAS float* s = scr + (8 * c) * 33 + n;
        v4u o; o.x = pk2(s[0 * 33], s[1 * 33]); o.y = pk2(s[2 * 33], s[3 * 33]); o.z = pk2(s[4 * 33], s[5 * 33]); o.w = pk2(s[6 * 33], s[7 * 33]);
        *(v4u*)(J.WT + (size_t)(n0 + n) * J.K + k0 + 8 * c) = o; }
    asm volatile("s_waitcnt lgkmcnt(0)" ::: "memory");
}
DI void row_to_bf16(const float* xrow, bf16* orow, float* ssqrow, int lane) {
    const f32x4* xr = (const f32x4*)xrow + lane; f32x4 v[4]; float s = 0.f;
#pragma unroll
    for (int j = 0; j < 4; ++j) { v[j] = xr[64 * j]; s += (v[j][0] * v[j][0] + v[j][1] * v[j][1]) + (v[j][2] * v[j][2] + v[j][3] * v[j][3]); }
    s = wave_sum(s);
    v2u* o8 = (v2u*)orow + lane;
#pragma unroll
    for (int j = 0; j < 4; ++j) { v2u w; w.x = pk2(v[j][0], v[j][1]); w.y = pk2(v[j][2], v[j][3]); o8[64 * j] = w; }
    if (lane < 16) ssqrow[lane] = lane == 0 ? s : 0.f;
}
DI void rope_entry(float* rope, int idx) {
    const int p = idx >> 3, i = idx & 7;
    const double pos = p < 2048 ? (double)p : (double)(8192 + (p - 2048));
    const double inv = i == 0 ? 1.0 : i == 1 ? 0.1939227447486858 : i == 2 ? 0.03760603093086394 : i == 3 ? 0.007292664737217109 : i == 4 ? 0.0014142135623730955
                     : i == 5 ? 0.00027424817567620724 : i == 6 ? 5.318295896944988e-05 : 1.0313385377212461e-05;
    const double ang = pos * inv, n = __builtin_rint(ang * 0.15915494309189535), r = (ang - n * 6.283185307179586) - n * 2.4492935982947064e-16, r2 = r * r;
    double s = 1.0, c = 1.0;
#pragma unroll
    for (int k = 14; k >= 1; --k) { s = 1.0 - r2 * s * (1.0 / (double)((2 * k) * (2 * k + 1))); c = 1.0 - r2 * c * (1.0 / (double)((2 * k - 1) * (2 * k))); }
    rope[p * 16 + i] = (float)c; rope[p * 16 + 8 + i] = (float)(r * s);
}

constexpr int ATT_V = 36864;
struct KVSrc { const float* kf; const float* vf; long stridef; int nf;
               const bf16* kb; const bf16* vb; long strideb; int blo, bhi; };
template <int NKT> DI void attn_stage(LAS unsigned char* lds, const KVSrc& s, int tid) {
    const int key = tid >> 1, half = tid & 1;
    if (key < NKT * 32) {
        v4u kq[4], vq[4];
        if (key < s.nf) { const float* kp = s.kf + (long)key * s.stridef + half * 32; const float* vp = s.vf + (long)key * s.stridef + half * 32;
#pragma unroll
            for (int j = 0; j < 4; ++j) { kq[j] = pk8(*(const f32x4*)(kp + 8 * j), *(const f32x4*)(kp + 8 * j + 4)); vq[j] = pk8(*(const f32x4*)(vp + 8 * j), *(const f32x4*)(vp + 8 * j + 4)); } }
        else if (key >= s.blo && key < s.bhi) { const bf16* kp = s.kb + (long)key * s.strideb + half * 32; const bf16* vp = s.vb + (long)key * s.strideb + half * 32;
#pragma unroll
            for (int j = 0; j < 4; ++j) { kq[j] = *(const v4u*)(kp + 8 * j); vq[j] = *(const v4u*)(vp + 8 * j); } }
        else {
#pragma unroll
            for (int j = 0; j < 4; ++j) { kq[j] = (v4u){0u, 0u, 0u, 0u}; vq[j] = (v4u){0u, 0u, 0u, 0u}; } }
#pragma unroll
        for (int j = 0; j < 4; ++j) *(LAS v4u*)(lds + key * 144 + half * 64 + j * 16) = kq[j];
#pragma unroll
        for (int j = 0; j < 4; ++j)
#pragma unroll
            for (int w = 0; w < 4; ++w) { const unsigned word = vq[j][w]; const int d = half * 32 + j * 8 + 2 * w;
                *(LAS unsigned short*)(lds + ATT_V + d * 520 + key * 2) = (unsigned short)(word & 0xffffu);
                *(LAS unsigned short*)(lds + ATT_V + (d + 1) * 520 + key * 2) = (unsigned short)(word >> 16); }
    }
}
template <int NKT, bool SINK> DI void attn_core(const LAS unsigned char* lds, const bf16x8 (&qf)[4], int lo, int hi, float sink2, f32x16 (&o)[2], int lane, int t0) {
    const int r = lane & 31, hh = lane >> 5;
    float m = SINK ? sink2 : -INFINITY, l = (SINK && hh == 0) ? 1.f : 0.f;
#pragma unroll
    for (int i = 0; i < 16; ++i) { o[0][i] = 0.f; o[1][i] = 0.f; }
#pragma unroll 1
    for (int t = 0; t < NKT; ++t) {
        f32x16 st;
#pragma unroll
        for (int i = 0; i < 16; ++i) st[i] = 0.f;
#pragma unroll
        for (int d0 = 0; d0 < 4; ++d0) { const bf16x8 kf = *(const LAS bf16x8*)(lds + (32 * (t0 + t) + r) * 144 + (d0 * 16 + 8 * hh) * 2);
            st = __builtin_amdgcn_mfma_f32_32x32x16_bf16(kf, qf[d0], st, 0, 0, 0); }
        float tm = -INFINITY;
#pragma unroll
        for (int i = 0; i < 16; ++i) { const int s = 32 * (t0 + t) + (i & 3) + 8 * (i >> 2) + 4 * hh; const float v = (s >= lo && s <= hi) ? st[i] : -INFINITY; st[i] = v; tm = fmaxf(tm, v); }
        tm = fmaxf(tm, __shfl_xor(tm, 32));
        const float mn = fmaxf(m, tm), ms = (mn == -INFINITY) ? 0.f : mn, alpha = __builtin_amdgcn_exp2f(m - ms);
        m = mn; l *= alpha;
#pragma unroll
        for (int i = 0; i < 16; ++i) { o[0][i] *= alpha; o[1][i] *= alpha; }
#pragma unroll
        for (int i = 0; i < 16; ++i) { const float p = __builtin_amdgcn_exp2f(st[i] - ms); st[i] = p; l += p; }
#pragma unroll
        for (int s2 = 0; s2 < 2; ++s2) {
            v4u pw; pw.x = pk2(st[8 * s2 + 0], st[8 * s2 + 1]); pw.y = pk2(st[8 * s2 + 2], st[8 * s2 + 3]); pw.z = pk2(st[8 * s2 + 4], st[8 * s2 + 5]); pw.w = pk2(st[8 * s2 + 6], st[8 * s2 + 7]);
            const bf16x8 pb = __builtin_bit_cast(bf16x8, pw);
#pragma unroll
            for (int dt = 0; dt < 2; ++dt) { const LAS unsigned char* vp = lds + ATT_V + (32 * dt + r) * 520 + (32 * (t0 + t) + 16 * s2 + 4 * hh) * 2;
                const s16x4 lo4 = *(const LAS s16x4*)vp, hi4 = *(const LAS s16x4*)(vp + 16);
                const bf16x8 va = __builtin_shufflevector(lo4, hi4, 0, 1, 2, 3, 4, 5, 6, 7);
                o[dt] = __builtin_amdgcn_mfma_f32_32x32x16_bf16(va, pb, o[dt], 0, 0, 0); } }
    }
    l += __shfl_xor(l, 32);
    const float inv = 1.0f / l;
#pragma unroll
    for (int i = 0; i < 16; ++i) { o[0][i] *= inv; o[1][i] *= inv; }
}
template <int NKT, bool SINK> DI void attn_wave(const LAS unsigned char* lds, const bf16* qptr, int lo, int hi, float sink2, bf16* optr, bool valid, int lane, int t0 = 0) {
    const int hh = lane >> 5; bf16x8 qf[4];
#pragma unroll
    for (int d0 = 0; d0 < 4; ++d0) qf[d0] = *(const bf16x8*)(qptr + d0 * 16 + 8 * hh);
    f32x16 o[2]; attn_core<NKT, SINK>(lds, qf, lo, hi, sink2, o, lane, t0);
    if (valid) {
#pragma unroll
        for (int dt = 0; dt < 2; ++dt)
#pragma unroll
            for (int g = 0; g < 4; ++g) { v2u w; w.x = pk2(o[dt][4 * g], o[dt][4 * g + 1]); w.y = pk2(o[dt][4 * g + 2], o[dt][4 * g + 3]); *(v2u*)(optr + 32 * dt + 8 * g + 4 * hh) = w; } }
}

struct Ptrs {
    const float* in[28]; float* out; unsigned char* ws;
    float *o_y, *o_glap, *o_glas, *o_kp, *o_vp, *o_ks, *o_vs, *o_mk, *o_mv;
    float *rope, *ssq, *ssqm, *gdv, *ut; bf16 *xb, *mpb, *mkv, *big, *mix, *kvb;
};
DI void unit_mem_prompt(const Ptrs& P, LAS unsigned char* lds, int L, int u, int tid) {
    const int b = u >> 5, h = (u >> 3) & 3, qb = u & 7, lane = tid & 63, w = tid >> 6;
    KVSrc s; s.kf = nullptr; s.vf = nullptr; s.stridef = 0; s.nf = 0; s.kb = P.mkv + (size_t)(b * 256) * 1024 + L * 512 + h * 64; s.vb = s.kb + 256; s.strideb = 1024; s.blo = 0; s.bhi = 256;
    attn_stage<8>(lds, s, tid); __syncthreads();
    const int row = b * SEQL + qb * 256 + 32 * w + (lane & 31);
    const bf16* qptr = (L == 0) ? P.big + (size_t)row * AINW + 2304 + 64 * h : P.big + (size_t)row * 1024 + 768 + 64 * h;
    attn_wave<8, false>(lds, qptr, 0, 255, 0.f, P.mix + (size_t)row * 1024 + 768 + 64 * h, true, lane);
    __syncthreads();
}
DI void unit_mem_sample(const Ptrs& P, LAS unsigned char* lds, int L, int u, int tid) {
    const int b = u >> 2, h = u & 3, lane = tid & 63, w = tid >> 6;
    KVSrc s; const size_t off = ((size_t)((L * 128 + b) * 256) * 4 + h) * 64; s.kf = P.in[5] + off; s.vf = P.in[6] + off; s.stridef = 256; s.nf = 256; s.kb = nullptr; s.vb = nullptr; s.strideb = 0; s.blo = 0; s.bhi = 0;
    attn_stage<8>(lds, s, tid); __syncthreads();
    if (w == 0) { const int r = lane & 31, row = MP + 4 * b + (r & 3);
        const bf16* qptr = (L == 0) ? P.big + (size_t)row * AINW + 2304 + 64 * h : P.big + (size_t)row * 1024 + 768 + 64 * h;
        attn_wave<8, false>(lds, qptr, 0, 255, 0.f, P.mix + (size_t)row * 1024 + 768 + 64 * h, r < 4, lane); }
    __syncthreads();
}
DI void unit_swa_prompt(const Ptrs& P, LAS unsigned char* lds, int u, int tid) {
    const int b = u / 96, rem = u % 96, kvh = rem >> 5, nblk = (rem & 31) >> 1, gp = rem & 1, lane = tid & 63, w = tid >> 6;
    KVSrc s; s.kf = nullptr; s.vf = nullptr; s.stridef = 0; s.nf = 0; s.kb = P.kvb + ((long)(b * SEQL + (nblk - 1) * 128)) * 384 + kvh * 64; s.vb = s.kb + 192; s.strideb = 384; s.blo = nblk == 0 ? 128 : 0; s.bhi = 256;
    attn_stage<8>(lds, s, tid); __syncthreads();
    const int hq = kvh * 4 + gp * 2 + (w >> 2), qi = 32 * (w & 3) + (lane & 31), row = b * SEQL + nblk * 128 + qi;
    const int lo = (qi + 1 > s.blo) ? qi + 1 : s.blo;
    attn_wave<5, true>(lds, P.big + (size_t)row * 1024 + hq * 64, lo, qi + 128, P.in[25][hq] * LOG2E, P.mix + (size_t)row * 1024 + hq * 64, true, lane, w & 3);
    __syncthreads();
}
DI void unit_swa_sample(const Ptrs& P, LAS unsigned char* lds, int u, int tid) {
    const int b = u / 3, kvh = u % 3, lane = tid & 63, w = tid >> 6;
    KVSrc s; const size_t off = ((size_t)(b * 128) * 3 + kvh) * 64; s.kf = P.in[3] + off; s.vf = P.in[4] + off; s.stridef = 192; s.nf = 128;
    s.kb = P.kvb + ((long)(MP + 4 * b) - 128) * 384 + kvh * 64; s.vb = s.kb + 192; s.strideb = 384; s.blo = 128; s.bhi = 132;
    attn_stage<5>(lds, s, tid); __syncthreads();
    if (w == 0) { const int r = lane & 31, g = (r >> 2) & 3, qi = r & 3, hq = kvh * 4 + g, row = MP + 4 * b + qi;
        attn_wave<5, true>(lds, P.big + (size_t)row * 1024 + hq * 64, qi + 1, qi + 128, P.in[25][hq] * LOG2E, P.mix + (size_t)row * 1024 + hq * 64, r < 16, lane); }
    __syncthreads();
}

constexpr int GL_LA = 0, GL_QP = 24576, GL_KP = 37888, GL_G16 = 51200, GL_WG = 55296, GL_BG = 61440, GL_SEG = 61824, GL_VT = 63488, GL_ST = 91136, GL_AM = 131072;
DI float fexp(float x) { return __builtin_amdgcn_exp2f(x * LOG2E); }
DI float log_sig16(float z) { return (fminf(z, 0.f) - 0.6931471805599453f * __builtin_amdgcn_logf(1.0f + __builtin_amdgcn_exp2f(-LOG2E * fabsf(z)))) * 0.0625f; }
DI void gla_common(const Ptrs& P, LAS unsigned char* lds, int r0, int h, int tid) {
    LAS float* LA = (LAS float*)(lds + GL_LA); LAS float* G16 = (LAS float*)(lds + GL_G16); LAS float* WG = (LAS float*)(lds + GL_WG); LAS float* BG = (LAS float*)(lds + GL_BG); LAS float* SEG = (LAS float*)(lds + GL_SEG);
    if (tid < 256) { const int i = tid >> 2, q4 = tid & 3; const v2u w = *(const v2u*)(P.big + (size_t)(r0 + i) * AINW + 2560 + q4 * 4);
        LAS float* g = G16 + i * 16 + q4 * 4; g[0] = bflo(w.x); g[1] = bfhi(w.x); g[2] = bflo(w.y); g[3] = bfhi(w.y); }
    if (tid < 384) { const int idx = tid * 4, j = idx / 96, d = idx % 96; *(LAS f32x4*)(WG + j * 96 + d) = *(const f32x4*)(P.in[18] + j * 384 + 96 * h + d); }
    if (tid < 96) BG[tid] = P.in[19][96 * h + tid];
    __syncthreads();
#pragma unroll
    for (int k = 0; k < 12; ++k) { const int idx = tid + 512 * k, i = idx / 96, d = idx % 96; float z = BG[d];
#pragma unroll
        for (int j = 0; j < 16; ++j) z += G16[i * 16 + j] * WG[j * 96 + d];
        LA[i * 96 + d] = log_sig16(z); }
    __syncthreads();
    float loc[16]; const int d = tid % 96, sg = tid / 96;
    if (tid < 384) { float s = 0.f;
#pragma unroll
        for (int k = 0; k < 16; ++k) { s += LA[(sg * 16 + k) * 96 + d]; loc[k] = s; }
        SEG[sg * 96 + d] = s; }
    __syncthreads();
    if (tid < 384) { float off = 0.f;
#pragma unroll
        for (int s2 = 0; s2 < 3; ++s2) if (s2 < sg) off += SEG[s2 * 96 + d];
#pragma unroll
        for (int k = 0; k < 16; ++k) LA[(sg * 16 + k) * 96 + d] = loc[k] + off; }
    __syncthreads();
}
DI void gla_stage_vt(const Ptrs& P, LAS unsigned char* lds, int r0, int h, int tid) {
    const int j = tid >> 3, sg = tid & 7; const bf16* row = P.big + (size_t)(r0 + j) * AINW + 768 + 192 * h + sg * 24;
#pragma unroll
    for (int q = 0; q < 3; ++q) { const v4u w = *(const v4u*)(row + q * 8);
#pragma unroll
        for (int e = 0; e < 4; ++e) { const int vv = sg * 24 + q * 8 + 2 * e;
            *(LAS unsigned short*)(lds + GL_VT + vv * 144 + j * 2) = (unsigned short)(w[e] & 0xffffu);
            *(LAS unsigned short*)(lds + GL_VT + (vv + 1) * 144 + j * 2) = (unsigned short)(w[e] >> 16); } }
}
DI void unit_gla_pass1(const Ptrs& P, LAS unsigned char* lds, int unit, int tid) {
    const int b = unit >> 7, h = (unit >> 5) & 3, c = unit & 31, r0 = b * SEQL + 64 * c, lane = tid & 63, w = tid >> 6, fr = lane & 15, fq = lane >> 4;
    gla_common(P, lds, r0, h, tid);
    const LAS float* LA = (const LAS float*)(lds + GL_LA);
    { const int j = tid >> 3, sg = tid & 7; const bf16* row = P.big + (size_t)(r0 + j) * AINW + 384 + 96 * h + sg * 12;
#pragma unroll
        for (int q = 0; q < 3; ++q) { const v2u wv = *(const v2u*)(row + q * 4); const float kv[4] = {bflo(wv.x), bfhi(wv.x), bflo(wv.y), bfhi(wv.y)};
#pragma unroll
            for (int e = 0; e < 4; ++e) { const int d = sg * 12 + q * 4 + e; *(LAS unsigned short*)(lds + GL_QP + d * 144 + j * 2) = f2bf(kv[e] * fexp(LA[63 * 96 + d] - LA[j * 96 + d])); } } }
    gla_stage_vt(P, lds, r0, h, tid);
    if (tid < 96) P.gdv[(size_t)unit * 96 + tid] = fexp(LA[63 * 96 + tid]);
    __syncthreads();
    float* ut = P.ut + (size_t)unit * 18432;
#pragma unroll 1
    for (int k = 0; k < 9; ++k) { const int tile = w + 8 * k, tv = tile / 6, td = tile % 6; f32x4 acc = {0.f, 0.f, 0.f, 0.f};
#pragma unroll
        for (int ks = 0; ks < 2; ++ks) { const bf16x8 a = *(const LAS bf16x8*)(lds + GL_VT + (tv * 16 + fr) * 144 + (ks * 32 + fq * 8) * 2), bb = *(const LAS bf16x8*)(lds + GL_QP + (td * 16 + fr) * 144 + (ks * 32 + fq * 8) * 2);
            acc = __builtin_amdgcn_mfma_f32_16x16x32_bf16(a, bb, acc, 0, 0, 0); }
#pragma unroll
        for (int rg = 0; rg < 4; ++rg) ut[(tv * 16 + fq * 4 + rg) * 96 + td * 16 + fr] = acc[rg]; }
    __syncthreads();
}
DI void unit_gla_pass3(const Ptrs& P, LAS unsigned char* lds, int unit, int tid) {
    const int b = unit >> 7, h = (unit >> 5) & 3, c = unit & 31, r0 = b * SEQL + 64 * c, lane = tid & 63, w = tid >> 6, fr = lane & 15, fq = lane >> 4;
    gla_common(P, lds, r0, h, tid);
    const LAS float* LA = (const LAS float*)(lds + GL_LA);
    { const int j = tid >> 3, sg = tid & 7; const bf16* row = P.big + (size_t)(r0 + j) * AINW + 96 * h + sg * 12;
#pragma unroll
        for (int q = 0; q < 3; ++q) { const int d = sg * 12 + q * 4; const v2u wq = *(const v2u*)(row + q * 4), wk = *(const v2u*)(row + 384 + q * 4);
            const float e0 = fexp(LA[j * 96 + d]), e1 = fexp(LA[j * 96 + d + 1]), e2 = fexp(LA[j * 96 + d + 2]), e3 = fexp(LA[j * 96 + d + 3]);
            v2u oq, ok; oq.x = pk2(bflo(wq.x) * e0, bfhi(wq.x) * e1); oq.y = pk2(bflo(wq.y) * e2, bfhi(wq.y) * e3);
            ok.x = pk2(bflo(wk.x) / e0, bfhi(wk.x) / e1); ok.y = pk2(bflo(wk.y) / e2, bfhi(wk.y) / e3);
            *(LAS v2u*)(lds + GL_QP + (j * 104 + d) * 2) = oq; *(LAS v2u*)(lds + GL_KP + (j * 104 + d) * 2) = ok; } }
    gla_stage_vt(P, lds, r0, h, tid);
    { const float* st = P.ut + (size_t)unit * 18432;
#pragma unroll
        for (int k = 0; k < 9; ++k) { const int idx = tid + 512 * k, vv = idx / 24, d4 = (idx % 24) * 4; const f32x4 sv = *(const f32x4*)(st + (size_t)idx * 4);
            v2u o; o.x = pk2(sv[0], sv[1]); o.y = pk2(sv[2], sv[3]); *(LAS v2u*)(lds + GL_ST + (vv * 104 + d4) * 2) = o; } }
    __syncthreads();
#pragma unroll
    for (int k = 0; k < 2; ++k) { const int tile = 2 * w + k, ti = tile >> 2, tj = tile & 3; f32x4 acc = {0.f, 0.f, 0.f, 0.f};
        if (tj <= ti) {
#pragma unroll
            for (int ks = 0; ks < 3; ++ks) { const bf16x8 a = *(const LAS bf16x8*)(lds + GL_QP + ((ti * 16 + fr) * 104 + ks * 32 + fq * 8) * 2), bb = *(const LAS bf16x8*)(lds + GL_KP + ((tj * 16 + fr) * 104 + ks * 32 + fq * 8) * 2);
                acc = __builtin_amdgcn_mfma_f32_16x16x32_bf16(a, bb, acc, 0, 0, 0); } }
#pragma unroll
        for (int rg = 0; rg < 4; ++rg) { const int i = ti * 16 + fq * 4 + rg, j = tj * 16 + fr; *(LAS unsigned short*)(lds + GL_AM + (i * 72 + j) * 2) = f2bf((j <= i) ? acc[rg] : 0.f); } }
    __syncthreads();
    f32x4 oacc[6];
#pragma unroll
    for (int k = 0; k < 6; ++k) { const int tile = w + 8 * k, ti = tile & 3, tv = tile >> 2; f32x4 acc = {0.f, 0.f, 0.f, 0.f};
#pragma unroll
        for (int ks = 0; ks < 2; ++ks) { const bf16x8 a = *(const LAS bf16x8*)(lds + GL_AM + ((ti * 16 + fr) * 72 + ks * 32 + fq * 8) * 2), bb = *(const LAS bf16x8*)(lds + GL_VT + ((tv * 16 + fr) * 72 + ks * 32 + fq * 8) * 2);
            acc = __builtin_amdgcn_mfma_f32_16x16x32_bf16(a, bb, acc, 0, 0, 0); }
#pragma unroll
        for (int ks = 0; ks < 3; ++ks) { const bf16x8 a = *(const LAS bf16x8*)(lds + GL_QP + ((ti * 16 + fr) * 104 + ks * 32 + fq * 8) * 2), bb = *(const LAS bf16x8*)(lds + GL_ST + ((tv * 16 + fr) * 104 + ks * 32 + fq * 8) * 2);
            acc = __builtin_amdgcn_mfma_f32_16x16x32_bf16(a, bb, acc, 0, 0, 0); }
        oacc[k] = acc; }
    __syncthreads();
    LAS float* OB = (LAS float*)lds;
#pragma unroll
    for (int k = 0; k < 6; ++k) { const int tile = w + 8 * k, ti = tile & 3, tv = tile >> 2;
#pragma unroll
        for (int rg = 0; rg < 4; ++rg) OB[(ti * 16 + fq * 4 + rg) * 196 + tv * 16 + fr] = oacc[k][rg]; }
    __syncthreads();
    { const int i = tid >> 3, sg = tid & 7; f32x4 ov[6]; float ss = 0.f;
#pragma unroll
        for (int e = 0; e < 6; ++e) { ov[e] = *(const LAS f32x4*)(OB + i * 196 + sg * 24 + 4 * e); ss += (ov[e][0] * ov[e][0] + ov[e][1] * ov[e][1]) + (ov[e][2] * ov[e][2] + ov[e][3] * ov[e][3]); }
        ss += __shfl_xor(ss, 1); ss += __shfl_xor(ss, 2); ss += __shfl_xor(ss, 4);
        const float rstd = 1.0f / sqrtf(ss * (1.0f / 192.0f) + 1e-6f);
        const bf16* rrow = P.big + (size_t)(r0 + i) * AINW + 1536 + 192 * h + sg * 24; const float* gn = P.in[20] + sg * 24; bf16* orow = P.mix + (size_t)(r0 + i) * 1024 + 192 * h + sg * 24;
#pragma unroll
        for (int q = 0; q < 3; ++q) { const v4u rw = *(const v4u*)(rrow + q * 8); const f32x4 g0 = *(const f32x4*)(gn + q * 8), g1 = *(const f32x4*)(gn + q * 8 + 4); const f32x4 a = ov[2 * q], bq = ov[2 * q + 1];
            f32x4 y0, y1;
            y0[0] = a[0] * rstd * g0[0] * silu_f(bflo(rw.x)); y0[1] = a[1] * rstd * g0[1] * silu_f(bfhi(rw.x)); y0[2] = a[2] * rstd * g0[2] * silu_f(bflo(rw.y)); y0[3] = a[3] * rstd * g0[3] * silu_f(bfhi(rw.y));
            y1[0] = bq[0] * rstd * g1[0] * silu_f(bflo(rw.z)); y1[1] = bq[1] * rstd * g1[1] * silu_f(bfhi(rw.z)); y1[2] = bq[2] * rstd * g1[2] * silu_f(bflo(rw.w)); y1[3] = bq[3] * rstd * g1[3] * silu_f(bfhi(rw.w));
            *(v4u*)(orow + q * 8) = pk8(y0, y1); } }
    __syncthreads();
}
DI void unit_gla_rec(const Ptrs& P, LAS unsigned char* lds, int u, int tid) {
    const int b = u >> 2, h = u & 3, lane = tid & 63;
    LAS float* EG = (LAS float*)lds; LAS float* QS = EG + 384; LAS float* KS = QS + 384; LAS float* VS = KS + 384; LAS float* RS = VS + 768; LAS float* OP = RS + 768;
    LAS float* G16 = (LAS float*)(lds + GL_G16); LAS float* WG = (LAS float*)(lds + GL_WG); LAS float* BG = (LAS float*)(lds + GL_BG);
    const bf16* rows = P.big + (size_t)(MP + 4 * b) * AINW;
    if (tid < 64) G16[tid] = bf2f(rows[(size_t)(tid >> 4) * AINW + 2560 + (tid & 15)]);
    if (tid < 384) { const int idx = tid * 4, j = idx / 96, d = idx % 96; *(LAS f32x4*)(WG + j * 96 + d) = *(const f32x4*)(P.in[18] + j * 384 + 96 * h + d);
        const int t = tid / 96, dd = tid % 96; QS[tid] = bf2f(rows[(size_t)t * AINW + 96 * h + dd]); KS[tid] = bf2f(rows[(size_t)t * AINW + 384 + 96 * h + dd]); }
    if (tid < 96) BG[tid] = P.in[19][96 * h + tid];
#pragma unroll
    for (int k = 0; k < 2; ++k) { const int idx = tid + 512 * k; if (idx < 768) { const int t = idx / 192, vv = idx % 192; VS[idx] = bf2f(rows[(size_t)t * AINW + 768 + 192 * h + vv]); RS[idx] = bf2f(rows[(size_t)t * AINW + 1536 + 192 * h + vv]); } }
    __syncthreads();
    if (tid < 384) { const int t = tid / 96, d = tid % 96; float z = BG[d];
#pragma unroll
        for (int j = 0; j < 16; ++j) z += G16[t * 16 + j] * WG[j * 96 + d];
        EG[tid] = fexp(log_sig16(z)); }
    __syncthreads();
    if (tid < 384) { const int vv = tid % 192, kh = tid / 192; float S[48];
        const float* sin_ = P.in[2] + ((size_t)(b * 4 + h) * 96 + 48 * kh) * 192 + vv; float* sout = P.o_glas + ((size_t)(b * 4 + h) * 96 + 48 * kh) * 192 + vv;
#pragma unroll
        for (int kk = 0; kk < 48; ++kk) S[kk] = sin_[kk * 192];
#pragma unroll
        for (int t = 0; t < 4; ++t) { float a = 0.f; const float vt = VS[t * 192 + vv];
#pragma unroll
            for (int kk = 0; kk < 48; ++kk) { const int d = 48 * kh + kk; S[kk] = EG[t * 96 + d] * S[kk] + KS[t * 96 + d] * vt; a += QS[t * 96 + d] * S[kk]; }
            OP[(kh * 4 + t) * 192 + vv] = a; }
#pragma unroll
        for (int kk = 0; kk < 48; ++kk) sout[kk * 192] = S[kk]; }
    __syncthreads();
    if (tid < 256) { const int t = tid >> 6; float ov[3]; float ss = 0.f;
#pragma unroll
        for (int k = 0; k < 3; ++k) { const int vv = lane + 64 * k; ov[k] = OP[t * 192 + vv] + OP[(4 + t) * 192 + vv]; ss += ov[k] * ov[k]; }
        ss = wave_sum(ss); const float rstd = 1.0f / sqrtf(ss * (1.0f / 192.0f) + 1e-6f);
        bf16* orow = P.mix + (size_t)(MP + 4 * b + t) * 1024 + 192 * h;
#pragma unroll
        for (int k = 0; k < 3; ++k) { const int vv = lane + 64 * k; orow[vv] = f2bf(ov[k] * rstd * P.in[20][vv] * silu_f(RS[t * 192 + vv])); } }
    __syncthreads();
}

struct Args { const float* in[28]; float* out; unsigned char* ws; int ph_lo, ph_hi; };
constexpr int N_PHASES = 18;
template <class Epi> DI void run_gemm(LAS unsigned char* lds, const bf16* A, const bf16* Bt, int M, int N, int K, const Epi& E) {
    pg8::Gemm g{A, Bt, M, N, K}; pg8::StaticOrder S; S.init(M, N, (int)gridDim.x, (int)blockIdx.x);
    pg8::gemm_phase<Epi, pg8::StaticOrder, true, true>(lds, g, S, E);
}
__global__ void __launch_bounds__(512, 2) yoco_fwd(Args args) {
    extern __shared__ __attribute__((aligned(16))) unsigned char lds_raw[];
    LAS unsigned char* lds = (LAS unsigned char*)lds_raw;
    const int tid = threadIdx.x, lane = tid & 63, wave = __builtin_amdgcn_readfirstlane(tid >> 6);
    const int G = gridDim.x, bid = blockIdx.x;
    Ptrs P;
#pragma unroll
    for (int i = 0; i < 28; ++i) P.in[i] = args.in[i];
    P.out = args.out; P.ws = args.ws;
    P.o_y = args.out; P.o_glap = args.out + 17301504; P.o_glas = P.o_glap + 589824; P.o_kp = P.o_glas + 9437184; P.o_vp = P.o_kp + 196608; P.o_ks = P.o_vp + 196608; P.o_vs = P.o_ks + 3145728;
    P.o_mk = P.o_vs + 3145728; P.o_mv = P.o_mk + 1048576;
    P.rope = (float*)(args.ws + WS_ROPE); P.ssq = (float*)(args.ws + WS_SSQ); P.ssqm = (float*)(args.ws + WS_SSQM); P.gdv = (float*)(args.ws + WS_GDV); P.ut = (float*)(args.ws + WS_UT);
    P.xb = (bf16*)(args.ws + WS_XB); P.mpb = (bf16*)(args.ws + WS_MPB); P.mkv = (bf16*)(args.ws + WS_MKV); P.big = (bf16*)(args.ws + WS_BIG); P.mix = (bf16*)(args.ws + WS_MIX); P.kvb = (bf16*)(args.ws + WS_KVB);
    bf16* const wgu = (bf16*)(args.ws + WS_WGU); bf16* const wd = (bf16*)(args.ws + WS_WD);
    bf16* const wain = (bf16*)(args.ws + WS_WAIN); bf16* const waout = (bf16*)(args.ws + WS_WAOUT); bf16* const wbin = (bf16*)(args.ws + WS_WBIN); bf16* const wbout = (bf16*)(args.ws + WS_WBOUT);
    bf16* const wkv = (bf16*)(args.ws + WS_WKV); bf16* const wmkv = (bf16*)(args.ws + WS_WMKV);
    constexpr size_t WGU_STRIDE = 12 * MiB / 2, WD_STRIDE = 5632 * 1024 / 2;

    volatile LAS unsigned* MISC = (volatile LAS unsigned*)(lds + MISC_OFF);
    for (int u = tid; u < 128; u += 512) MISC[u] = 0u;
    __syncthreads();
    const int lo = args.ph_lo, hi = args.ph_hi;
    const bool multi = (hi - lo) > 1;
    XcdBarrier bar; bar.bar = (unsigned*)(args.ws + WS_CTL); bar.x = 0; bar.st = nullptr;
    if (multi) bar = xcd_barrier_post((unsigned*)(args.ws + WS_CTL), MISC + 8);
#ifndef PH_MASK
#define PH_MASK 0x3ffff
#endif
#define IN(k) (((PH_MASK >> (k)) & 1) && lo <= (k) && (k) < hi)
#define SEAM(k) do { if (IN(k) && IN((k) + 1)) xcd_barrier(bar); } while (0)
    float* const xres = P.o_y;

    if (IN(0)) for (int rep = 0; rep < REP_P0; ++rep) {
        LAS float* scr = (LAS float*)(lds + wave * 16384);
        const int gw = bid * 8 + wave, NGW = G * 8;
        constexpr int I_GU = 16 * 176, I_WD = 44 * 32, I_AIN = 16 * 88, I_SQ = 16 * 32, I_KV = 16 * 16, I_MK = 16 * 16;
        constexpr int NITEMS = 4 * I_GU + 4 * I_WD + I_AIN + 3 * I_SQ + I_KV + 2 * I_MK;
        for (int it = gw; it < NITEMS; it += NGW) {
            int r = it; TJob J;
            if (r < 4 * I_GU) { const int f = r / I_GU; r -= f * I_GU; const int l = f >> 1, second = f & 1;
                J.W = (second ? P.in[13] : P.in[9]) + (size_t)l * 1024 * 5632; J.gain = (second ? P.in[12] : P.in[8]) + l * 1024; J.WT = wgu + f * WGU_STRIDE; J.K = 1024; J.N = 5632; J.nd = 5632; J.kind = TK_GU; }
            else if ((r -= 4 * I_GU) < 4 * I_WD) { const int f = r / I_WD; r -= f * I_WD; const int l = f >> 1, second = f & 1;
                J.W = (second ? P.in[14] : P.in[10]) + (size_t)l * 2816 * 1024; J.gain = nullptr; J.WT = wd + f * WD_STRIDE; J.K = 2816; J.N = 1024; J.nd = 1024; J.kind = TK_ID; }
            else if ((r -= 4 * I_WD) < I_AIN) { J.W = P.in[17]; J.gain = P.in[11]; J.WT = wain; J.K = 1024; J.N = 2576; J.nd = 2816; J.kind = TK_AIN; }
            else if ((r -= I_AIN) < I_SQ) { J.W = P.in[21]; J.gain = nullptr; J.WT = waout; J.K = 1024; J.N = 1024; J.nd = 1024; J.kind = TK_ID; }
            else if ((r -= I_SQ) < I_SQ) { J.W = P.in[24]; J.gain = P.in[11] + 1024; J.WT = wbin; J.K = 1024; J.N = 1024; J.nd = 1024; J.kind = TK_BIN; }
            else if ((r -= I_SQ) < I_SQ) { J.W = P.in[26]; J.gain = nullptr; J.WT = wbout; J.K = 1024; J.N = 1024; J.nd = 1024; J.kind = TK_ID; }
            else if ((r -= I_SQ) < I_KV) { J.W = P.in[23]; J.gain = P.in[22]; J.WT = wkv; J.K = 1024; J.N = 384; J.nd = 512; J.kind = TK_KV; }
            else { r -= I_KV; const int l = r / I_MK; r -= l * I_MK; J.W = P.in[16] + (size_t)l * 1024 * 512; J.gain = P.in[15] + l * 1024; J.WT = wmkv + (size_t)l * 512 * 1024; J.K = 1024; J.N = 512; J.nd = 512; J.kind = TK_ID; }
            p0_transpose_item(J, scr, r, lane);
        }
        for (int m = gw; m < MT + 2048; m += 2 * NGW) {
            const float* xr[2]; bf16* orow[2]; float* sq[2]; bool ok[2];
#pragma unroll
            for (int q = 0; q < 2; ++q) { const int mm = m + q * NGW; ok[q] = mm < MT + 2048; const int mc = ok[q] ? mm : m;
                if (mc < MP) { xr[q] = P.in[0] + (size_t)mc * DM; orow[q] = P.xb + (size_t)mc * DM; sq[q] = P.ssq + (size_t)mc * 16; }
                else if (mc < MT) { xr[q] = P.in[1] + (size_t)(mc - MP) * DM; orow[q] = P.xb + (size_t)mc * DM; sq[q] = P.ssq + (size_t)mc * 16; }
                else { xr[q] = P.in[7] + (size_t)(mc - MT) * DM; orow[q] = P.mpb + (size_t)(mc - MT) * DM; sq[q] = P.ssqm + (size_t)(mc - MT) * 16; } }
            f32x4 v[2][4];
#pragma unroll
            for (int q = 0; q < 2; ++q)
#pragma unroll
                for (int j = 0; j < 4; ++j) v[q][j] = ((const f32x4*)xr[q])[lane + 64 * j];
#pragma unroll
            for (int q = 0; q < 2; ++q) { float ssum = 0.f;
#pragma unroll
                for (int j = 0; j < 4; ++j) ssum += (v[q][j][0] * v[q][j][0] + v[q][j][1] * v[q][j][1]) + (v[q][j][2] * v[q][j][2] + v[q][j][3] * v[q][j][3]);
                ssum = wave_sum(ssum);
                if (ok[q]) {
#pragma unroll
                    for (int j = 0; j < 4; ++j) { v2u w; w.x = pk2(v[q][j][0], v[q][j][1]); w.y = pk2(v[q][j][2], v[q][j][3]); ((v2u*)orow[q])[lane + 64 * j] = w; }
                    if (lane < 16) sq[q][lane] = lane == 0 ? ssum : 0.f; } }
        }
        const int gt = bid * 512 + tid, NT = G * 512;
        for (int idx = gt; idx < 2052 * 8; idx += NT) rope_entry(P.rope, idx);
        for (int idx0 = gt; idx0 < 2 * 128 * 5952; idx0 += 4 * NT) { f32x4 tv[4]; float* dp[4];
#pragma unroll
            for (int q = 0; q < 4; ++q) { const int idx = idx0 + q * NT; dp[q] = nullptr;
                if (idx < 2 * 128 * 5952) { const int which = idx / (128 * 5952), rem = idx % (128 * 5952), b = rem / 5952, e = rem % 5952;
                    tv[q] = *(const f32x4*)((which ? P.in[4] : P.in[3]) + (size_t)b * 24576 + 768 + 4 * e); dp[q] = (which ? P.o_vs : P.o_ks) + (size_t)b * 24576 + 4 * e; } }
#pragma unroll
            for (int q = 0; q < 4; ++q) if (dp[q]) *(f32x4*)dp[q] = tv[q]; }
    }
    SEAM(0);
    if (IN(1)) {
        run_gemm(lds, P.mpb, wmkv, 2048, 1024, 1024, pg8::EpiMemKV{P.ssqm, P.mkv, P.o_mk, P.o_mv});
        run_gemm(lds, P.xb, wgu, MT, NGU, 1024, pg8::EpiGU{P.ssq, P.big});
    }
    SEAM(1);
    if (IN(2)) run_gemm(lds, P.big, wd, MT, 1024, FF, pg8::EpiDown{nullptr, P.in[0], P.in[1], xres, P.xb, P.ssq, 0.5f});
    SEAM(2);
    if (IN(3)) run_gemm(lds, P.xb, wain, MT, AINW, 1024, pg8::EpiRowScale{P.ssq, P.big, AINW});
    SEAM(3);
    if (IN(4)) for (int rep = 0; rep < REP_P4; ++rep) { int bz = bid; asm volatile("" : "+s"(bz));
        for (int u = bz; u < 1024; u += G) unit_gla_pass1(P, lds, u, tid);
        for (int u = bz; u < 512; u += G) unit_gla_rec(P, lds, u, tid);
        for (int u = bz; u < 512; u += G) unit_mem_sample(P, lds, 0, u, tid);
        for (int u = bz; u < 256; u += G) unit_mem_prompt(P, lds, 0, u, tid);
    }
    SEAM(4);
    if (IN(5)) {
        const int gt = bid * 512 + tid, NT = G * 512;
        for (int idx = gt; idx < 32 * 4608; idx += NT) { const int bh = idx / 4608, e4 = idx % 4608, vv = e4 / 24, d4 = (e4 % 24) * 4;
            float* p = P.ut + (size_t)bh * 32 * 18432 + (size_t)e4 * 4; const float* dv = P.gdv + (size_t)bh * 32 * 96 + d4;
            f32x4 S = {0.f, 0.f, 0.f, 0.f};
#pragma unroll 8
            for (int c = 0; c < 32; ++c) { const f32x4 uv = *(const f32x4*)(p + (size_t)c * 18432); const f32x4 dd = *(const f32x4*)(dv + c * 96); *(f32x4*)(p + (size_t)c * 18432) = S; S = dd * S + uv; }
            float* o = P.o_glap + ((size_t)bh * 96 + d4) * 192 + vv; o[0] = S[0]; o[192] = S[1]; o[384] = S[2]; o[576] = S[3]; }
    }
    SEAM(5);
    if (IN(6)) for (int rep = 0; rep < REP_P6; ++rep) { for (int u = bid; u < 1024; u += G) unit_gla_pass3(P, lds, u, tid); }
    SEAM(6);
    if (IN(7)) run_gemm(lds, P.mix, waout, MT, 1024, 1024, pg8::EpiDown{nullptr, xres, xres + (size_t)MP * 1024, xres, P.xb, P.ssq, 1.0f});
    SEAM(7);
    if (IN(8)) run_gemm(lds, P.xb, wgu + WGU_STRIDE, MT, NGU, 1024, pg8::EpiGU{P.ssq, P.big});
    SEAM(8);
    if (IN(9)) run_gemm(lds, P.big, wd + WD_STRIDE, MT, 1024, FF, pg8::EpiDown{nullptr, xres, xres + (size_t)MP * 1024, xres, P.xb, P.ssq, 0.5f});
    SEAM(9);
    if (IN(10)) {
        run_gemm(lds, P.xb, wkv, MT, 512, 1024, pg8::EpiKV{P.ssq, P.kvb, P.rope, P.o_kp, P.o_vp, P.o_ks, P.o_vs});
        run_gemm(lds, P.xb, wgu + 2 * WGU_STRIDE, MT, NGU, 1024, pg8::EpiGU{P.ssq, P.big});
    }
    SEAM(10);
    if (IN(11)) run_gemm(lds, P.big, wd + 2 * WD_STRIDE, MT, 1024, FF, pg8::EpiDown{nullptr, xres, xres + (size_t)MP * 1024, xres, P.xb, P.ssq, 0.5f});
    SEAM(11);
    if (IN(12)) run_gemm(lds, P.xb, wbin, MT, 1024, 1024, pg8::EpiInB{P.ssq, P.big, P.rope});
    SEAM(12);
    if (IN(13)) for (int rep = 0; rep < REP_P13; ++rep) { int bz = bid; asm volatile("" : "+s"(bz));
#ifndef UM2
#define UM2 15
#endif
        if (UM2 & 1) for (int u = bz; u < 768; u += G) unit_swa_prompt(P, lds, u, tid);
        if (UM2 & 2) for (int u = bz; u < 384; u += G) unit_swa_sample(P, lds, u, tid);
        if (UM2 & 4) for (int u = bz; u < 512; u += G) unit_mem_sample(P, lds, 1, u, tid);
        if (UM2 & 8) for (int u = bz; u < 256; u += G) unit_mem_prompt(P, lds, 1, u, tid);
    }
    SEAM(13);
    if (IN(14)) run_gemm(lds, P.mix, wbout, MT, 1024, 1024, pg8::EpiDown{nullptr, xres, xres + (size_t)MP * 1024, xres, P.xb, P.ssq, 1.0f});
    SEAM(14);
    if (IN(15)) run_gemm(lds, P.xb, wgu + 3 * WGU_STRIDE, MT, NGU, 1024, pg8::EpiGU{P.ssq, P.big});
    SEAM(15);
    if (IN(16)) run_gemm(lds, P.big, wd + 3 * WD_STRIDE, MT, 1024, FF, pg8::EpiDown{nullptr, xres, xres + (size_t)MP * 1024, xres, nullptr, P.ssq, 0.5f});
    SEAM(16);
    if (IN(17)) {
        const int gw = bid * 8 + wave, NGW = G * 8;
        for (int m = gw; m < MT; m += NGW) { f32x4* xr = (f32x4*)(xres + (size_t)m * DM) + lane; const f32x4* gr = (const f32x4*)P.in[27] + lane;
            float s = lane < 16 ? P.ssq[(size_t)m * 16 + lane] : 0.f; s = wave_sum(s); const float rstd = 1.0f / sqrtf(s * (1.0f / 1024.0f) + 1e-6f);
#pragma unroll
            for (int j = 0; j < 4; ++j) { const f32x4 v = xr[64 * j], g = gr[64 * j]; xr[64 * j] = v * rstd * g; } }
    }
#undef IN
#undef SEAM
}

extern "C" void kernel_launch(void* const* d_in, const int* in_sizes, int n_in, void* d_out, int out_size, void* d_ws, size_t ws_size, hipStream_t stream) {
    static int grid = 0;
    if (grid == 0) {
        if (n_in != 28 || ws_size < WS_END) { fprintf(stderr, "kernel_launch: expected 28 inputs and >= %zu bytes of workspace; got %d, %zu\n", (size_t)WS_END, n_in, ws_size); grid = -1; return; }
        int dev = 0, cus = 0, per_cu = 0;
        if (hipGetDevice(&dev) != hipSuccess || hipDeviceGetAttribute(&cus, hipDeviceAttributeMultiprocessorCount, dev) != hipSuccess) { grid = -1; return; }
        if (hipFuncSetAttribute((const void*)yoco_fwd, hipFuncAttributeMaxDynamicSharedMemorySize, LDS_BYTES) != hipSuccess) { fprintf(stderr, "kernel_launch: hipFuncSetAttribute failed\n"); grid = -1; return; }
        if (hipOccupancyMaxActiveBlocksPerMultiprocessor(&per_cu, (const void*)yoco_fwd, 512, LDS_BYTES) != hipSuccess || per_cu < 1) fprintf(stderr, "kernel_launch: occupancy query reports %d blocks per CU\n", per_cu);
        (void)hipGetLastError();
        grid = cus;
    }
    if (grid < 0) return;
    Args a{};
    for (int i = 0; i < 28; ++i) a.in[i] = (const float*)d_in[i];
    a.out = (float*)d_out; a.ws = (unsigned char*)d_ws;
#if MK_ONE_LAUNCH
    (void)hipMemsetAsync((char*)d_ws + WS_CTL, 0, CTL_ZERO_BYTES, stream);
    a.ph_lo = 0; a.ph_hi = N_PHASES;
    hipLaunchKernelGGL(yoco_fwd, dim3(grid), dim3(512), LDS_BYTES, stream, a);
#else
    for (int p = 0; p < N_PHASES; ++p) { a.ph_lo = p; a.ph_hi = p + 1; hipLaunchKernelGGL(yoco_fwd, dim3(grid), dim3(512), LDS_BYTES, stream, a); }
#endif
}
```
